# Optimizing an MI355X kernel written in HIP

```python
import math
import jax
import jax.numpy as jnp
from jax import lax
import numpy as np

D_MODEL = 2048
BATCH = 4
SEQ = 4096
DEPTH = 1

GRID_W = 64
CTX_LEN = 256
D_MIX = D_MODEL
D_RWKV = D_MIX // 2
RWKV_HEAD = 64
N_RWKV_HEADS = D_RWKV // RWKV_HEAD
DECAY_LORA = 64
AAA_LORA = 64
GATE_LORA = 160
D_S5 = D_MIX - D_RWKV
S5_GROUP = 16
N_S5_GROUPS = D_S5 // S5_GROUP
S5_STATE = 64
D_FF = 5632
N_MOD = 6
RMS_EPS = 1e-6
LNX_EPS = 64e-5
RWKV_SIZES = (D_RWKV, D_RWKV, D_RWKV, GATE_LORA, DECAY_LORA, DECAY_LORA, AAA_LORA, AAA_LORA)
RWKV_IN = 3 * D_RWKV + GATE_LORA + 2 * DECAY_LORA + 2 * AAA_LORA
N_IN = RWKV_IN + D_S5

kernel_name = "hybrid_rwkv7_s5_prefix_dit_block"


def _rms_norm(x, g):
    xf = x.astype(jnp.float32)
    y = xf * lax.rsqrt(jnp.mean(xf * xf, axis=-1, keepdims=True) + RMS_EPS)
    return (y * g.astype(jnp.float32)).astype(x.dtype)


def _modulate(h, shift, scale):
    return h * (1.0 + scale) + shift


def _neighbours(p, rows):
    b, t, ch = p.shape
    q = p.reshape(b, rows, t // rows, ch)
    q = jnp.pad(q, ((0, 0), (0, 0), (1, 1), (0, 0)))
    return q[:, :, :-2].reshape(b, t, ch), q[:, :, 2:].reshape(b, t, ch)


def _split_cols(z, sizes):
    out, start = [], 0
    for s in sizes:
        out.append(z[..., start:start + s])
        start += s
    return out


def _wkv7(r, decay, k, v, kk, a, s0, reverse, want_output):
    tm = lambda z: jnp.moveaxis(z, 1, 0)
    xs = (tm(decay), tm(k), tm(v), tm(kk), tm(kk * a))
    if want_output:
        xs = xs + (tm(r),)

    def step(s, inp):
        w_t, k_t, v_t, kk_t, b_t = inp[:5]
        sa = jnp.einsum('bhvk,bhk->bhv', s, kk_t)
        s = s * w_t[:, :, None, :] - sa[..., None] * b_t[:, :, None, :] + v_t[..., None] * k_t[:, :, None, :]
        y = jnp.einsum('bhvk,bhk->bhv', s, inp[5]) if want_output else None
        return s, y

    s_fin, ys = lax.scan(step, s0, xs, reverse=reverse)
    return (jnp.moveaxis(ys, 0, 1) if want_output else None), s_fin


def _zoh(a_re, a_im, log_step, b_re, b_im):
    f32 = jnp.float32
    a_re, a_im = a_re.astype(f32), a_im.astype(f32)
    b_re, b_im = b_re.astype(f32), b_im.astype(f32)
    dt = jnp.exp(log_step.astype(f32))[:, None]
    mag = jnp.exp(a_re * dt)
    ang = a_im * dt
    lam_re, lam_im = mag * jnp.cos(ang), mag * jnp.sin(ang)
    den = a_re * a_re + a_im * a_im
    nr = lam_re - 1.0
    f_re = (nr * a_re + lam_im * a_im) / den
    f_im = (lam_im * a_re - nr * a_im) / den
    bb_re = f_re[..., None] * b_re - f_im[..., None] * b_im
    bb_im = f_re[..., None] * b_im + f_im[..., None] * b_re
    return lam_re, lam_im, bb_re, bb_im


def _s5_scan(bu_re, bu_im, lam_re, lam_im, s0, reverse):
    a_re = jnp.broadcast_to(lam_re, bu_re.shape)
    a_im = jnp.broadcast_to(lam_im, bu_im.shape)

    def combine(e1, e2):
        a1r, a1i, b1r, b1i = e1
        a2r, a2i, b2r, b2i = e2
        return (a2r * a1r - a2i * a1i, a2r * a1i + a2i * a1r,
                a2r * b1r - a2i * b1i + b2r, a2r * b1i + a2i * b1r + b2i)

    ar, ai, sr, si = lax.associative_scan(combine, (a_re, a_im, bu_re, bu_im), reverse=reverse, axis=1)
    if s0 is not None:
        s0r, s0i = s0[0][:, None], s0[1][:, None]
        sr, si = sr + ar * s0r - ai * s0i, si + ar * s0i + ai * s0r
    return sr, si


def _token_mixer(h, rows, lp, init, want_output, want_states):
    f32 = jnp.float32
    bsz, t, _ = h.shape
    p = jnp.einsum('btd,dn->btn', h, lp['w_in'])
    q = p[..., :RWKV_IN]
    prev, nxt = _neighbours(q, rows)
    mu = lp['shift_mu']
    q = (q + mu[0] * (prev - q) + mu[1] * (nxt - q)).astype(f32)
    u = p[..., RWKV_IN:].astype(f32).reshape(bsz, t, N_S5_GROUPS, S5_GROUP)

    r, k, v, gd, wd_f, wd_b, ad_f, ad_b = _split_cols(q, RWKV_SIZES)
    heads = lambda z: z.reshape(bsz, t, N_RWKV_HEADS, RWKV_HEAD)
    kk = heads(k * lp['rwkv_k_k'])
    kk = kk / jnp.maximum(jnp.sqrt(jnp.sum(kk * kk, axis=-1, keepdims=True)), 1e-12)
    rh, vh = heads(r), heads(v)
    rwkv_y, rwkv_fin = [], []
    for d, (wd, ad) in enumerate(((wd_f, ad_f), (wd_b, ad_b))):
        w_log = -jax.nn.softplus(-(lp['rwkv_w0'][d] + jnp.tanh(wd) @ lp['rwkv_w_up'][d])) - 0.5
        decay = jnp.exp(-jnp.exp(w_log))
        a = jax.nn.sigmoid(lp['rwkv_a0'][d] + ad @ lp['rwkv_a_up'][d])
        kd = k * (1.0 + (a - 1.0) * lp['rwkv_k_a'])
        if init is None:
            s0 = jnp.zeros((bsz, N_RWKV_HEADS, RWKV_HEAD, RWKV_HEAD), f32)
        else:
            s0 = init['rwkv'][d]
        y, s_fin = _wkv7(rh, heads(decay), heads(kd), vh, kk, heads(a), s0, d == 1, want_output)
        rwkv_y.append(y)
        rwkv_fin.append(s_fin)

    s5_y, s5_fin = [], []
    for d in range(2):
        lam_re, lam_im, bb_re, bb_im = _zoh(lp['s5_a_re'][d], lp['s5_a_im'][d], lp['s5_log_step'][d],
                                            lp['s5_b_re'][d], lp['s5_b_im'][d])
        bu_re = jnp.einsum('gph,btgh->btgp', bb_re, u)
        bu_im = jnp.einsum('gph,btgh->btgp', bb_im, u)
        s0 = None if init is None else init['s5'][d]
        sr, si = _s5_scan(bu_re, bu_im, lam_re, lam_im, s0, d == 1)
        if want_output:
            s5_y.append(jnp.einsum('ghp,btgp->btgh', lp['s5_c_re'][d], sr)
                        - jnp.einsum('ghp,btgp->btgh', lp['s5_c_im'][d], si))
        if want_states:
            idx = -1 if d == 0 else 0
            s5_fin.append((sr[:, idx], si[:, idx]))

    states = {'rwkv': rwkv_fin, 's5': s5_fin} if want_states else None
    if not want_output:
        return None, states

    yh = rwkv_y[0] + rwkv_y[1]
    mean = jnp.mean(yh, axis=-1, keepdims=True)
    var = jnp.mean(jnp.square(yh - mean), axis=-1, keepdims=True)
    yn = ((yh - mean) * lax.rsqrt(var + LNX_EPS)).reshape(bsz, t, D_RWKV) * lp['lnx_w'] + lp['lnx_b']
    bonus = (jnp.sum(rh * heads(k) * lp['rwkv_r_k'], axis=-1, keepdims=True) * vh).reshape(bsz, t, D_RWKV)
    g = jax.nn.sigmoid(gd) @ lp['rwkv_g_up']
    o_rwkv = (yn + bonus) * g

    y5 = (s5_y[0] + s5_y[1] + lp['s5_d'].reshape(N_S5_GROUPS, S5_GROUP) * u).reshape(bsz, t, D_S5)
    z = jax.nn.gelu(y5)
    o_s5 = z * jax.nn.sigmoid(z @ lp['s5_glu_w'] + lp['s5_glu_b'])

    o = jnp.concatenate([o_rwkv, o_s5], axis=-1).astype(h.dtype)
    return jnp.einsum('btm,md->btd', o, lp['w_out']), states


def _conv_ffn(h, rows, w_up, conv_w, conv_b, w_down):
    up = jnp.einsum('btd,df->btf', h, w_up)
    gate, val = up[..., :D_FF], up[..., D_FF:]
    prev, nxt = _neighbours(gate, rows)
    gate = conv_w[0] * prev + conv_w[1] * gate + conv_w[2] * nxt + conv_b
    return jnp.einsum('btf,fd->btd', jax.nn.gelu(gate) * val, w_down)


def setup_inputs(seed: int = 0) -> dict:
    key = jax.random.key(seed)
    ks = jax.random.split(key, 40)
    f32 = jnp.float32
    L, G, P, H, N = DEPTH, N_S5_GROUPS, S5_STATE, N_RWKV_HEADS, RWKV_HEAD

    def nrm(i, shape, scale):
        return jax.random.normal(ks[i], shape, f32) * scale

    return {
        'x': nrm(0, (BATCH, SEQ, D_MODEL), 1.0),
        'c': nrm(1, (BATCH, D_MODEL), 1.0),
        'ctx': nrm(2, (BATCH, CTX_LEN, D_MODEL), 1.0),
        'c_ctx': nrm(3, (D_MODEL,), 1.0),
        'mod_w': nrm(4, (L, D_MODEL, N_MOD * D_MODEL), 0.5 * D_MODEL ** -0.5),
        'mod_b': nrm(5, (L, N_MOD * D_MODEL), 0.02),
        'norm_mix_g': 1.0 + nrm(6, (L, D_MODEL), 0.02),
        'w_in': nrm(7, (L, D_MODEL, N_IN), D_MODEL ** -0.5),
        'shift_mu': jax.random.uniform(ks[8], (L, 2, RWKV_IN), f32, 0.0, 0.5),
        'rwkv_w0': jax.random.uniform(ks[9], (L, 2, D_RWKV), f32, -6.5, -1.5),
        'rwkv_w_up': nrm(10, (L, 2, DECAY_LORA, D_RWKV), 0.5 * DECAY_LORA ** -0.5),
        'rwkv_a0': nrm(11, (L, 2, D_RWKV), 0.1),
        'rwkv_a_up': nrm(12, (L, 2, AAA_LORA, D_RWKV), 0.5 * AAA_LORA ** -0.5),
        'rwkv_g_up': nrm(13, (L, GATE_LORA, D_RWKV), GATE_LORA ** -0.5),
        'rwkv_k_k': 0.85 + nrm(14, (L, D_RWKV), 0.02),
        'rwkv_k_a': 1.0 + nrm(15, (L, D_RWKV), 0.02),
        'rwkv_r_k': nrm(16, (L, H, N), 0.1),
        'lnx_w': 1.0 + nrm(17, (L, D_RWKV), 0.02),
        'lnx_b': nrm(18, (L, D_RWKV), 0.02),
        's5_a_re': -0.5 + nrm(19, (L, 2, G, P), 0.01),
        's5_a_im': jnp.pi * jnp.arange(P, dtype=f32) + nrm(20, (L, 2, G, P), 0.01),
        's5_log_step': jax.random.uniform(ks[21], (L, 2, G), f32, math.log(1e-3), math.log(1e-1)),
        's5_b_re': nrm(22, (L, 2, G, P, S5_GROUP), (2 * S5_GROUP) ** -0.5),
        's5_b_im': nrm(23, (L, 2, G, P, S5_GROUP), (2 * S5_GROUP) ** -0.5),
        's5_c_re': nrm(24, (L, 2, G, S5_GROUP, P), P ** -0.5),
        's5_c_im': nrm(25, (L, 2, G, S5_GROUP, P), P ** -0.5),
        's5_d': nrm(26, (L, D_S5), 1.0),
        's5_glu_w': nrm(27, (L, D_S5, D_S5), D_S5 ** -0.5),
        's5_glu_b': nrm(28, (L, D_S5), 0.02),
        'w_out': nrm(29, (L, D_MIX, D_MODEL), D_MIX ** -0.5),
        'norm_ffn_g': 1.0 + nrm(30, (L, D_MODEL), 0.02),
        'ffn_w_up': nrm(31, (L, D_MODEL, 2 * D_FF), D_MODEL ** -0.5),
        'ffn_conv_w': nrm(32, (L, 3, D_FF), 3.0 ** -0.5),
        'ffn_conv_b': nrm(33, (L, D_FF), 0.02),
        'ffn_w_down': nrm(34, (L, D_FF, D_MODEL), D_FF ** -0.5),
        'final_norm_g': 1.0 + nrm(35, (D_MODEL,), 0.02),
    }


def reference(x, c, ctx, c_ctx, mod_w, mod_b, norm_mix_g, w_in, shift_mu, rwkv_w0, rwkv_w_up, rwkv_a0,
              rwkv_a_up, rwkv_g_up, rwkv_k_k, rwkv_k_a, rwkv_r_k, lnx_w, lnx_b, s5_a_re, s5_a_im,
              s5_log_step, s5_b_re, s5_b_im, s5_c_re, s5_c_im, s5_d, s5_glu_w, s5_glu_b, w_out,
              norm_ffn_g, ffn_w_up, ffn_conv_w, ffn_conv_b, ffn_w_down, final_norm_g):
    rows = x.shape[1] // GRID_W
    for i in range(DEPTH):
        lp = {
            'w_in': w_in[i], 'shift_mu': shift_mu[i],
            'rwkv_w0': rwkv_w0[i], 'rwkv_w_up': rwkv_w_up[i], 'rwkv_a0': rwkv_a0[i], 'rwkv_a_up': rwkv_a_up[i],
            'rwkv_g_up': rwkv_g_up[i], 'rwkv_k_k': rwkv_k_k[i], 'rwkv_k_a': rwkv_k_a[i], 'rwkv_r_k': rwkv_r_k[i],
            'lnx_w': lnx_w[i], 'lnx_b': lnx_b[i],
            's5_a_re': s5_a_re[i], 's5_a_im': s5_a_im[i], 's5_log_step': s5_log_step[i],
            's5_b_re': s5_b_re[i], 's5_b_im': s5_b_im[i], 's5_c_re': s5_c_re[i], 's5_c_im': s5_c_im[i],
            's5_d': s5_d[i], 's5_glu_w': s5_glu_w[i], 's5_glu_b': s5_glu_b[i], 'w_out': w_out[i],
        }
        last = i == DEPTH - 1
        mod_x = (jax.nn.silu(c) @ mod_w[i] + mod_b[i])[:, None, :]
        mod_c = (jax.nn.silu(c_ctx)[None] @ mod_w[i] + mod_b[i])[:, None, :]
        sh_x, sc_x, gt_x, shf_x, scf_x, gtf_x = jnp.split(mod_x, N_MOD, axis=-1)
        sh_c, sc_c, gt_c, shf_c, scf_c, gtf_c = jnp.split(mod_c, N_MOD, axis=-1)

        hc = _modulate(_rms_norm(ctx, norm_mix_g[i]), sh_c, sc_c)
        ctx_mix, ctx_states = _token_mixer(hc, 1, lp, None, not last, True)

        hx = _modulate(_rms_norm(x, norm_mix_g[i]), sh_x, sc_x)
        x_mix, _ = _token_mixer(hx, rows, lp, ctx_states, True, False)
        x = x + gt_x * x_mix
        hx = _modulate(_rms_norm(x, norm_ffn_g[i]), shf_x, scf_x)
        x = x + gtf_x * _conv_ffn(hx, rows, ffn_w_up[i], ffn_conv_w[i], ffn_conv_b[i], ffn_w_down[i])

        if not last:
            ctx = ctx + gt_c * ctx_mix
            hc = _modulate(_rms_norm(ctx, norm_ffn_g[i]), shf_c, scf_c)
            ctx = ctx + gtf_c * _conv_ffn(hc, 1, ffn_w_up[i], ffn_conv_w[i], ffn_conv_b[i], ffn_w_down[i])
    return _rms_norm(x, final_norm_g)
```

```cpp
#include <hip/hip_runtime.h>
#include <hip/hip_cooperative_groups.h>
#include <cstdio>
#include <type_traits>
namespace cg = cooperative_groups;

#define LAS __attribute__((address_space(3)))
typedef unsigned short bf16_t;
typedef short bf16x8 __attribute__((ext_vector_type(8)));
typedef float f32x4 __attribute__((ext_vector_type(4)));

constexpr int D = 2048, NB = 4, T = 4096, TCX = 256, TP = 4352, MT = NB * TP, ML = NB * T;
constexpr int NIN = 4512, NINP = 4608, RIN = 3488, DFF = 5632;
constexpr int LDS_BYTES = 131072 + 16;
constexpr size_t MiB = 1048576;
constexpr size_t WS_BAR = 3 * MiB + 3 * MiB / 4;
constexpr size_t WS_MODPART = 0, WS_MODV = 2 * MiB, WS_BONUS = 2 * MiB + MiB / 2, WS_KTAB = 4 * MiB, WS_WT_IN = 6 * MiB, WS_WT_GLU = 24 * MiB,
                 WS_WT_OUT = 26 * MiB, WS_WT_WA = 34 * MiB, WS_WT_G = 36 * MiB, WS_BT_S5 = 37 * MiB, WS_TC_S5 = 45 * MiB;
constexpr size_t WS_MODPART2 = 64 * MiB, WS_KTAB4 = 72 * MiB;
constexpr size_t WS_B = 64 * MiB, WS_P = WS_B, WS_W = WS_B, WS_YF = WS_B + 80 * MiB, WS_YB = WS_B + 112 * MiB;
constexpr size_t WS_C = 217 * MiB, WS_HX = WS_C, WS_NLDF = WS_C, WS_NLDB = WS_C + 34 * MiB, WS_AF = WS_C + 68 * MiB, WS_AB = WS_C + 102 * MiB,
                 WS_V = WS_C + 136 * MiB, WS_A2 = WS_C + 170 * MiB, WS_G = WS_C + 250 * MiB, WS_O = WS_C;
constexpr size_t WS_H = 64 * MiB, WS_HX2 = 240 * MiB, WS_WT_UP = 304 * MiB, WS_WT_DOWN = 348 * MiB;
constexpr size_t WS_NEED = 512 * MiB;
constexpr size_t DO_R = 0, DO_K = 34 * MiB, DO_KK = 68 * MiB, DO_ASMALL = 102 * MiB, DO_Z = 0;

struct Params { const float* in[36]; float* out; unsigned char* ws; int ph_lo, ph_hi; };

typedef __bf16 bf16v2_t __attribute__((ext_vector_type(2)));
typedef float f32v2_t __attribute__((ext_vector_type(2)));
__device__ __forceinline__ unsigned cvt_pk_bf16(float lo, float hi) { const f32v2_t v = {lo, hi}; const bf16v2_t b = __builtin_convertvector(v, bf16v2_t); return __builtin_bit_cast(unsigned, b); }
__device__ __forceinline__ float bflo(unsigned u) { return __uint_as_float(u << 16); }
__device__ __forceinline__ float bfhi(unsigned u) { return __uint_as_float(u & 0xffff0000u); }
__device__ __forceinline__ float bf2f(bf16_t v) { return __uint_as_float(((unsigned)v) << 16); }
__device__ __forceinline__ bf16_t f2bf(float f) { return (bf16_t)(cvt_pk_bf16(f, 0.f) & 0xffffu); }
__device__ __forceinline__ void ld8(const bf16_t* p, float (&o)[8]) {
    const uint4 u = *(const uint4*)p;
    o[0] = bflo(u.x); o[1] = bfhi(u.x); o[2] = bflo(u.y); o[3] = bfhi(u.y); o[4] = bflo(u.z); o[5] = bfhi(u.z); o[6] = bflo(u.w); o[7] = bfhi(u.w);
}
__device__ __forceinline__ void ld8nt(const bf16_t* p, float (&o)[8]);
__device__ __forceinline__ void st8(bf16_t* p, const float (&v)[8]) {
    uint4 u; u.x = cvt_pk_bf16(v[0], v[1]); u.y = cvt_pk_bf16(v[2], v[3]); u.z = cvt_pk_bf16(v[4], v[5]); u.w = cvt_pk_bf16(v[6], v[7]); *(uint4*)p = u;
}
__device__ __forceinline__ void st4(bf16_t* p, float a, float b, float c, float d) { uint2 u; u.x = cvt_pk_bf16(a, b); u.y = cvt_pk_bf16(c, d); *(uint2*)p = u; }
typedef unsigned u32x4_nt __attribute__((ext_vector_type(4)));
__device__ __forceinline__ f32x4 ldnt4(const float* p) { return __builtin_nontemporal_load((const f32x4*)p); }
__device__ __forceinline__ void stnt4(float* p, f32x4 v) { __builtin_nontemporal_store(v, (f32x4*)p); }
__device__ __forceinline__ uint4 ldnt16(const bf16_t* p);
__device__ __forceinline__ uint4 ldnt16(const bf16_t* p) { const u32x4_nt v = __builtin_nontemporal_load((const u32x4_nt*)p); return make_uint4(v[0], v[1], v[2], v[3]); }
__device__ __forceinline__ void ld8nt(const bf16_t* p, float (&o)[8]) { const uint4 u = ldnt16(p); o[0] = bflo(u.x); o[1] = bfhi(u.x); o[2] = bflo(u.y); o[3] = bfhi(u.y); o[4] = bflo(u.z); o[5] = bfhi(u.z); o[6] = bflo(u.w); o[7] = bfhi(u.w); }
__device__ __forceinline__ float sigmoid_(float x) { return __builtin_amdgcn_rcpf(1.f + __expf(-x)); }
__device__ __forceinline__ float tanh_(float x) { return 1.f - 2.f * __builtin_amdgcn_rcpf(1.f + __expf(2.f * x)); }
__device__ __forceinline__ float gelu_(float x) { const float u = 1.5957691216f * (x + 0.044715f * x * x * x); return x * __builtin_amdgcn_rcpf(1.f + __expf(-u)); }
__device__ __forceinline__ void cis_(float ang, float& c, float& s) { float rev = ang * 0.15915494309f; rev -= rintf(rev); s = __builtin_amdgcn_sinf(rev); c = __builtin_amdgcn_cosf(rev); }
template <int CTRL> __device__ __forceinline__ float dpp_(float v) { return __int_as_float(__builtin_amdgcn_update_dpp(0, __float_as_int(v), CTRL, 0xF, 0xF, false)); }
__device__ __forceinline__ float reduce16(float x) { x += dpp_<0xB1>(x); x += dpp_<0x4E>(x); x += dpp_<0x141>(x); x += dpp_<0x140>(x); return x; }
__device__ __forceinline__ float wave_sum(float x) {
#pragma unroll
    for (int o = 32; o >= 1; o >>= 1) x += __shfl_xor(x, o, 64);
    return x;
}

namespace pg8 {
constexpr int BM = 256, BK = 64, HALF = 128, HTB = HALF * BK * 2, STAGE_BYTES = 8 * HTB, NXCD = 8, WGM = 8;
__host__ __device__ __forceinline__ int lds_byte(int r, int c) { const int st = (r >> 4) * 2 + (c >> 5), rr = r & 15, cc = c & 31, ob = rr * 64 + cc * 2; return st * 1024 + (ob ^ (((ob >> 9) & 1) << 5)); }
__host__ __device__ __forceinline__ void stage_rc(int b, int& R, int& C) { const int st = b / 1024, sb = b % 1024, swz = sb ^ (((sb >> 9) & 1) << 5); R = (st >> 1) * 16 + swz / 64; C = (st & 1) * 32 + (swz % 64) / 2; }
struct Unit { int pm, pn; };
struct Gemm { const bf16_t* A; const bf16_t* Bt; int K, lda, ldb; int krev = 0; };
struct StaticOrder {
    int nM, nN, nwg, G, c;
    __device__ void init(int M, int N, int G_, int c_) { nM = M / BM; nN = N / BM; nwg = nM * nN; G = G_; c = c_; }
    __device__ bool next(int i, Unit& u) const {
        const long L = (long)i * G + c; if (L >= nwg) return false;
        int wgid = (int)L; { const int q = nwg / NXCD, r = nwg % NXCD, xcd = wgid % NXCD, off = wgid / NXCD; wgid = (xcd < r ? xcd * (q + 1) : r * (q + 1) + (xcd - r) * q) + off; }
        const int nig = WGM * nN, gid = wgid / nig, fm = gid * WGM, gsz = (nM - fm) < WGM ? (nM - fm) : WGM;
        u.pm = fm + ((wgid % nig) % gsz); u.pn = (wgid % nig) / gsz; return true;
    }
};
struct LatentOrder {
    int G, c;
    __device__ bool next(int i, Unit& u) const { const long L = (long)i * G + c; if (L >= 256) return false; const int pml = (int)L >> 2; u.pm = (pml >> 4) * 17 + 1 + (pml & 15); u.pn = (int)L & 3; return true; }
};
struct GroupOrder4 {
    int G, c;
    __device__ bool next(int i, Unit& u) const { const long L = (long)i * G + c; if (L >= 256) return false; u.pn = (int)L >> 2; u.pm = u.pn * 5 + ((int)L & 3); return true; }
};
struct GroupOrder {
    int G, c;
    __device__ bool next(int i, Unit& u) const { const long L = (long)i * G + c; if (L >= 320) return false; u.pm = (int)L; u.pn = (int)L / 5; return true; }
};

template <class Epi, class Sched>
__device__ __forceinline__ void gemm_phase(LAS unsigned char* lds, const Gemm g, const Sched& S, const Epi& E, const int tid) {
    const int wid = __builtin_amdgcn_readfirstlane(tid >> 6), lane = tid & 63, wr = wid >> 2, wc = wid & 3, fr = lane & 15, fq = lane >> 4;
    const int K = g.K, nt = K / BK;
    unsigned voffA[2], voffB[2];
#pragma unroll
    for (int i = 0; i < 2; ++i) { int R, C; stage_rc(tid * 16 + i * 8192, R, C); voffA[i] = (unsigned)(R * g.lda + C) * 2u; voffB[i] = (unsigned)(R * g.ldb + C) * 2u; }
    const ptrdiff_t kstep = g.krev ? -(ptrdiff_t)(BK * 2) : (ptrdiff_t)(BK * 2);
    const size_t kbase = g.krev ? (size_t)(nt - 1) * (BK * 2) : 0;
    const size_t hstepA = (size_t)HALF * g.lda * 2, hstepB = (size_t)HALF * g.ldb * 2;
    const size_t tstepA = 2 * hstepA, tstepB = 2 * hstepB;
    const unsigned ldsw = (unsigned)wid * 1024u;
    const int aoff = lds_byte(wr * 64 + fr, fq * 8), boff = lds_byte(wc * 32 + fr, fq * 8);
#define PG8_SA(b, h) (((b) * 2 + (h)) * HTB)
#define PG8_SB(b, h) ((4 + (b) * 2 + (h)) * HTB)
#define PG8_STAGE(bufoff, gbase, voff) do { _Pragma("unroll") for (int _i = 0; _i < 2; ++_i) \
        __builtin_amdgcn_global_load_lds((const unsigned*)((const char*)(gbase) + (voff)[_i]), (LAS unsigned*)(lds + (bufoff) + ldsw + _i * 8192), 16, 0, 0); } while (0)
#define PG8_LDA(dst, b, h) do { _Pragma("unroll") for (int m = 0; m < 4; ++m) _Pragma("unroll") for (int k = 0; k < 2; ++k) dst[m][k] = *(const LAS bf16x8*)(lds + PG8_SA(b, h) + aoff + m * 2048 + k * 1024); } while (0)
#define PG8_LDB(dst, b, h) do { _Pragma("unroll") for (int n = 0; n < 2; ++n) _Pragma("unroll") for (int k = 0; k < 2; ++k) dst[n][k] = *(const LAS bf16x8*)(lds + PG8_SB(b, h) + boff + n * 2048 + k * 1024); } while (0)
#define PG8_MMA(ai, bj, At, Bt) do { __builtin_amdgcn_s_setprio(1); _Pragma("unroll") for (int m = 0; m < 4; ++m) _Pragma("unroll") for (int n = 0; n < 2; ++n) _Pragma("unroll") for (int k = 0; k < 2; ++k) \
        acc[ai][bj][m][n] = __builtin_amdgcn_mfma_f32_16x16x32_bf16(Bt[n][k], At[m][k], acc[ai][bj][m][n], 0, 0, 0); __builtin_amdgcn_s_setprio(0); } while (0)
#define PG8_WAIT_V(n) asm volatile("s_waitcnt vmcnt(" #n ")" ::: "memory")
#define PG8_WAIT_L(n) asm volatile("s_waitcnt lgkmcnt(" #n ")" ::: "memory")
#define PG8_BAR __builtin_amdgcn_s_barrier()
#define PG8_SCHED __builtin_amdgcn_sched_barrier(0)
    Unit cur, nxt; int ui = 0;
    if (!S.next(0, cur)) return;
    f32x4 acc[2][2][4][2];
#pragma unroll
    for (int a = 0; a < 2; ++a)
#pragma unroll
        for (int b = 0; b < 2; ++b)
#pragma unroll
            for (int m = 0; m < 4; ++m)
#pragma unroll
                for (int n = 0; n < 2; ++n) acc[a][b][m][n] = (f32x4){0.f, 0.f, 0.f, 0.f};
    bf16x8 At[4][2], B0[2][2], B1[2][2];
    const char* cA = (const char*)g.A + (size_t)cur.pm * tstepA + kbase; const char* cB = (const char*)g.Bt + (size_t)cur.pn * tstepB + kbase;
    PG8_STAGE(PG8_SB(0, 0), cB, voffB); PG8_STAGE(PG8_SA(0, 0), cA, voffA); PG8_STAGE(PG8_SB(0, 1), cB + hstepB, voffB); PG8_STAGE(PG8_SA(0, 1), cA + hstepA, voffA);
    if (wr == 1) PG8_BAR;
    PG8_WAIT_V(4); PG8_BAR;
    PG8_STAGE(PG8_SB(1, 0), cB + kstep, voffB); PG8_STAGE(PG8_SA(1, 0), cA + kstep, voffA); PG8_STAGE(PG8_SB(1, 1), cB + hstepB + kstep, voffB);
    PG8_WAIT_V(6); PG8_BAR;
    for (;;) {
        const bool has_next = S.next(ui + 1, nxt);
        const char* nA = has_next ? (const char*)g.A + (size_t)nxt.pm * tstepA + kbase : cA; const char* nB = has_next ? (const char*)g.Bt + (size_t)nxt.pn * tstepB + kbase : cB;
        for (int t = 0; t < nt; t += 2) {
            const bool last = (t == nt - 2);
            const char* a1 = cA + (ptrdiff_t)(t + 1) * kstep;
            const char* a2 = last ? nA : cA + (ptrdiff_t)(t + 2) * kstep; const char* b2 = last ? nB : cB + (ptrdiff_t)(t + 2) * kstep;
            const char* a3 = a2 + kstep; const char* b3 = b2 + kstep;
            PG8_LDB(B0, 0, 0); PG8_SCHED; PG8_LDA(At, 0, 0); PG8_STAGE(PG8_SA(1, 1), a1 + hstepA, voffA);
            PG8_WAIT_L(8); PG8_BAR; PG8_WAIT_L(0); PG8_MMA(0, 0, At, B0); PG8_BAR; PG8_SCHED;
            PG8_LDB(B1, 0, 1); PG8_STAGE(PG8_SB(0, 0), b2, voffB);
            PG8_BAR; PG8_WAIT_L(0); PG8_MMA(0, 1, At, B1); PG8_BAR;
            PG8_LDA(At, 0, 1); PG8_STAGE(PG8_SA(0, 0), a2, voffA);
            PG8_BAR; PG8_WAIT_L(0); PG8_MMA(1, 0, At, B0); PG8_BAR; PG8_SCHED;
            PG8_STAGE(PG8_SB(0, 1), b2 + hstepB, voffB);
            PG8_WAIT_V(6); PG8_BAR; PG8_MMA(1, 1, At, B1); PG8_BAR;
            PG8_LDB(B0, 1, 0); PG8_SCHED; PG8_LDA(At, 1, 0); PG8_STAGE(PG8_SA(0, 1), a2 + hstepA, voffA);
            PG8_WAIT_L(8); PG8_BAR; PG8_WAIT_L(0); PG8_MMA(0, 0, At, B0); PG8_BAR; PG8_SCHED;
            PG8_LDB(B1, 1, 1); PG8_STAGE(PG8_SB(1, 0), b3, voffB);
            PG8_BAR; PG8_WAIT_L(0); PG8_MMA(0, 1, At, B1); PG8_BAR;
            PG8_LDA(At, 1, 1); PG8_STAGE(PG8_SA(1, 0), a3, voffA);
            PG8_BAR; PG8_WAIT_L(0); PG8_MMA(1, 0, At, B0); PG8_BAR; PG8_SCHED;
            PG8_STAGE(PG8_SB(1, 1), b3 + hstepB, voffB);
            PG8_WAIT_V(6); PG8_BAR; PG8_MMA(1, 1, At, B1); PG8_BAR;
        }
        E(acc, cur, wr, wc, fr, fq);
        if (!has_next) break;
#pragma unroll
        for (int a = 0; a < 2; ++a)
#pragma unroll
            for (int b = 0; b < 2; ++b)
#pragma unroll
                for (int m = 0; m < 4; ++m)
#pragma unroll
                    for (int n = 0; n < 2; ++n) acc[a][b][m][n] = (f32x4){0.f, 0.f, 0.f, 0.f};
        cur = nxt; cA = nA; cB = nB; ++ui;
    }
    PG8_WAIT_V(0);
    if (wr == 0) PG8_BAR;
    PG8_BAR;
#undef PG8_SA
#undef PG8_SB
#undef PG8_STAGE
#undef PG8_LDA
#undef PG8_LDB
#undef PG8_MMA
#undef PG8_WAIT_V
#undef PG8_WAIT_L
#undef PG8_BAR
#undef PG8_SCHED
}
}
using pg8::Unit;

#define EPI_LOOP_ROWS for (int ai = 0; ai < 2; ++ai) for (int m = 0; m < 4; ++m)

struct EpiStoreBf16 {
    bf16_t* O; int ldc;
    __device__ __forceinline__ void operator()(const f32x4 (&acc)[2][2][4][2], const Unit& u, int wr, int wc, int fr, int fq) const {
        const int row0 = u.pm * 256 + wr * 64 + fr, col0 = u.pn * 256 + wc * 32 + 4 * fq;
#pragma unroll
        EPI_LOOP_ROWS { bf16_t* rowp = O + (size_t)(row0 + ai * 128 + m * 16) * ldc + col0;
#pragma unroll
            for (int bj = 0; bj < 2; ++bj)
#pragma unroll
                for (int n = 0; n < 2; ++n) { const f32x4 v = acc[ai][bj][m][n]; st4(rowp + bj * 128 + n * 16, v[0], v[1], v[2], v[3]); } }
    }
};
struct EpiStoreF32 {
    float* C; int ldc;
    __device__ __forceinline__ void operator()(const f32x4 (&acc)[2][2][4][2], const Unit& u, int wr, int wc, int fr, int fq) const {
        const int row0 = u.pm * 256 + wr * 64 + fr, col0 = wc * 32 + 4 * fq;
#pragma unroll
        EPI_LOOP_ROWS { float* rowp = C + (size_t)(row0 + ai * 128 + m * 16) * ldc + col0;
#pragma unroll
            for (int bj = 0; bj < 2; ++bj)
#pragma unroll
                for (int n = 0; n < 2; ++n) *(f32x4*)(rowp + bj * 128 + n * 16) = acc[ai][bj][m][n]; }
    }
};
struct EpiLoraWA {
    bf16_t *nldf, *nldb, *af, *ab; const float* w0; const float* a0;
    __device__ __forceinline__ void operator()(const f32x4 (&acc)[2][2][4][2], const Unit& u, int wr, int wc, int fr, int fq) const {
        const int h = u.pn, ch = 16 * wc + 4 * fq, c = 64 * h + ch;
        const int b = u.pm / 17, tp0 = (u.pm - b * 17) * 256 + wr * 64 + fr;
        const size_t idx0 = ((size_t)(b * 16 + h) * TP + tp0) * 64 + ch;
#pragma unroll
        for (int arr = 0; arr < 4; ++arr) {
            const int bj = arr & 1, n = arr >> 1;
            const f32x4 bias = *(const f32x4*)((n ? a0 : w0) + bj * 1024 + c);
            bf16_t* dst = (arr == 0 ? nldf : arr == 1 ? nldb : arr == 2 ? af : ab) + idx0;
            const float sc = n ? 1.f : 0.60653066f;
#pragma unroll
            for (int ai = 0; ai < 2; ++ai)
#pragma unroll
                for (int m = 0; m < 4; ++m) { const f32x4 v = acc[ai][bj][m][n];
                    st4(dst + (size_t)(ai * 128 + m * 16) * 64, sc * sigmoid_(bias[0] + v[0]), sc * sigmoid_(bias[1] + v[1]), sc * sigmoid_(bias[2] + v[2]), sc * sigmoid_(bias[3] + v[3])); }
            asm volatile("" ::: "memory");
        }
    }
};
struct EpiS5Y {
    bf16_t* Z;
    __device__ __forceinline__ void operator()(const f32x4 (&acc)[2][2][4][2], const Unit& u, int wr, int wc, int fr, int fq) const {
        const int g = u.pm / 5, lp = u.pm - g * 5;
#pragma unroll
        EPI_LOOP_ROWS {
            const int lr = lp * 256 + ai * 128 + wr * 64 + m * 16 + fr;
            { const int b = lr >> 8, sl = lr & 255;
#pragma unroll
                    for (int bj = 0; bj < 2; ++bj)
#pragma unroll
                        for (int n = 0; n < 2; ++n) { const int tau = 8 * bj + 2 * wc + n; const int t = sl * 16 + tau; const f32x4 v = acc[ai][bj][m][n];
                            st4(Z + (size_t)(b * T + t) * 1024 + g * 16 + 4 * fq, gelu_(v[0]), gelu_(v[1]), gelu_(v[2]), gelu_(v[3])); } }
        }
    }
};
struct EpiGLU {
    const bf16_t* Z; bf16_t* O; const float* bias;
    __device__ __forceinline__ void operator()(const f32x4 (&acc)[2][2][4][2], const Unit& u, int wr, int wc, int fr, int fq) const {
        const int row0 = u.pm * 256 + wr * 64 + fr, col0 = u.pn * 256 + wc * 32 + 4 * fq;
#pragma unroll
        EPI_LOOP_ROWS { const size_t row = row0 + ai * 128 + m * 16;
#pragma unroll
            for (int bj = 0; bj < 2; ++bj)
#pragma unroll
                for (int n = 0; n < 2; ++n) { const int col = col0 + bj * 128 + n * 16; const f32x4 v = acc[ai][bj][m][n]; const f32x4 bv = *(const f32x4*)(bias + col);
                    const uint2 zz = *(const uint2*)(Z + row * 1024 + col);
                    st4(O + row * 2048 + 1024 + col, bflo(zz.x) * sigmoid_(v[0] + bv[0]), bfhi(zz.x) * sigmoid_(v[1] + bv[1]), bflo(zz.y) * sigmoid_(v[2] + bv[2]), bfhi(zz.y) * sigmoid_(v[3] + bv[3])); } }
    }
};
struct EpiResid {
    const float* base; float* out; const float* gate;
    __device__ __forceinline__ void operator()(const f32x4 (&acc)[2][2][4][2], const Unit& u, int wr, int wc, int fr, int fq) const {
        const int row0 = u.pm * 256 + wr * 64 + fr, col0 = u.pn * 256 + wc * 32 + 4 * fq;
        const float* gp = gate + (size_t)((u.pm * 256) / T) * 12288;
#pragma unroll
        EPI_LOOP_ROWS { const size_t row = row0 + ai * 128 + m * 16;
#pragma unroll
            for (int bj = 0; bj < 2; ++bj)
#pragma unroll
                for (int n = 0; n < 2; ++n) { const int col = col0 + bj * 128 + n * 16; const f32x4 gv = *(const f32x4*)(gp + col); const f32x4 xv = *(const f32x4*)(base + row * 2048 + col);
                    *(f32x4*)(out + row * 2048 + col) = xv + gv * acc[ai][bj][m][n]; } }
    }
};
struct EpiFFNUp {
    bf16_t* H; const float* cw; const float* cb;
    __device__ __forceinline__ void operator()(const f32x4 (&acc)[2][2][4][2], const Unit& u, int wr, int wc, int fr, int fq) const {
        const int row0 = u.pm * 256 + wr * 64 + fr;
#pragma unroll
        for (int n = 0; n < 2; ++n) {
            const int f0 = u.pn * 128 + wc * 32 + n * 16 + 4 * fq;
            const f32x4 c0 = *(const f32x4*)(cw + f0), c1 = *(const f32x4*)(cw + DFF + f0), c2 = *(const f32x4*)(cw + 2 * DFF + f0), cbv = *(const f32x4*)(cb + f0);
#pragma unroll
            for (int ai = 0; ai < 2; ++ai) {
#pragma unroll
                for (int m = 0; m < 4; ++m) {
                    float o[4];
#pragma unroll
                    for (int j = 0; j < 4; ++j) {
                        const float gc = acc[ai][0][m][n][j];
                        const float rp = dpp_<0x121>(gc), rn = dpp_<0x12F>(gc);
                        const float pm1 = (m > 0) ? dpp_<0x121>(acc[ai][0][m > 0 ? m - 1 : 0][n][j]) : 0.f;
                        const float nm1 = (m < 3) ? dpp_<0x12F>(acc[ai][0][m < 3 ? m + 1 : 3][n][j]) : 0.f;
                        const float pv = (fr == 0) ? pm1 : rp, nv = (fr == 15) ? nm1 : rn;
                        const float gt = c0[j] * pv + c1[j] * gc + c2[j] * nv + cbv[j];
                        o[j] = gelu_(gt) * acc[ai][1][m][n][j];
                    }
                    st4(H + (size_t)(row0 + ai * 128 + m * 16) * DFF + f0, o[0], o[1], o[2], o[3]);
                }
            }
        }
    }
};

__device__ __forceinline__ int srccol(int kind, int n) { return kind == 3 ? (((n >> 7) & 1) * DFF + (n >> 8) * 128 + (n & 127)) : n; }
__device__ void transpose_weight(const float* src, int ldn, int nvalid, int K, int Np, int kind, bf16_t* dst, const int tid, const int woff = 0) {
    const int lane = tid & 63, gw = blockIdx.x * 8 + (tid >> 6), nw = gridDim.x * 8;
    const int ntn = Np / 64, ntile = ntn * (K / 64);
    for (int tl = (gw - woff % nw + nw) % nw; tl < ntile; tl += nw) {
        const int tk = tl / ntn, tn = tl - tk * ntn, n = tn * 64 + lane, k0 = tk * 64;
        const bool ok = n < nvalid; const float* sp = src + (size_t)k0 * ldn + (ok ? srccol(kind, n) : 0);
        float v[64];
#pragma unroll
        for (int i = 0; i < 64; ++i) v[i] = __builtin_nontemporal_load(sp + (size_t)i * ldn);
        bf16_t* dp = dst + (size_t)n * K + k0;
#pragma unroll
        for (int i = 0; i < 8; ++i) { uint4 u; u.x = cvt_pk_bf16(v[8 * i], v[8 * i + 1]); u.y = cvt_pk_bf16(v[8 * i + 2], v[8 * i + 3]); u.z = cvt_pk_bf16(v[8 * i + 4], v[8 * i + 5]); u.w = cvt_pk_bf16(v[8 * i + 6], v[8 * i + 7]);
            if (!ok) u = make_uint4(0u, 0u, 0u, 0u);
            *(uint4*)(dp + 8 * i) = u; }
    }
}
__device__ __forceinline__ void s5_lam(const Params& P, int d, int g, int p, float& lr, float& li, float& fre, float& fim) {
    const float dt = expf(P.in[21][d * 64 + g]); const float are = P.in[19][(d * 64 + g) * 64 + p], aim = P.in[20][(d * 64 + g) * 64 + p];
    const float mag = expf(are * dt); float c, s; cis_(aim * dt, c, s); lr = mag * c; li = mag * s;
    const float den = are * are + aim * aim, nr = lr - 1.f; fre = (nr * are + li * aim) / den; fim = (li * are - nr * aim) / den;
}

__device__ void phase0(const Params& P, float* ldsf, const int tid) {
    const int nblk = gridDim.x, blk = blockIdx.x;
    unsigned char* ws = P.ws;
    transpose_weight(P.in[7], NIN, NIN, 2048, NINP, 0, (bf16_t*)(ws + WS_WT_IN), tid);
    transpose_weight(P.in[27], 1024, 1024, 1024, 1024, 1, (bf16_t*)(ws + WS_WT_GLU), tid, 2304);
    transpose_weight(P.in[29], 2048, 2048, 2048, 2048, 2, (bf16_t*)(ws + WS_WT_OUT), tid, 2304 + 256);
    { bf16_t* wa = (bf16_t*)(ws + WS_WT_WA); const float* wup = P.in[10]; const float* aup = P.in[12];
      for (int id = blk * 512 + tid; id < 4096 * 256; id += nblk * 512) { const int n = id >> 8, k = id & 255; const int h = n >> 8, dir = (n >> 7) & 1, wc = (n >> 5) & 3, type = (n >> 4) & 1, fq = (n >> 2) & 3, j = n & 3;
          const int c = 64 * h + 16 * wc + 4 * fq + j, kb = k >> 6, kk = k & 63; float v = 0.f;
          if (type == 0) { if (kb == dir) v = wup[(dir * 64 + kk) * 1024 + c]; } else { if (kb == 2 + dir) v = aup[(dir * 64 + kk) * 1024 + c]; }
          wa[id] = f2bf(v); }
      bf16_t* wg = (bf16_t*)(ws + WS_WT_G); const float* gup = P.in[13];
      for (int id = blk * 512 + tid; id < 1024 * 256; id += nblk * 512) { const int n = id >> 8, k = id & 255; wg[id] = f2bf(k < 160 ? gup[k * 1024 + n] : 0.f); } }
    { float* mp = (float*)(ws + WS_MODPART2); const float* mw = P.in[4];
      for (int ch = blk; ch < 192; ch += nblk) { const int ks = ch / 6, col = ((ch - ks * 6) * 512 + tid) * 4;
          __syncthreads();
          if (tid < 320) { const int r = tid >> 6, kk = tid & 63; const float cv = (r < 4) ? P.in[1][r * 2048 + ks * 64 + kk] : P.in[3][ks * 64 + kk]; ldsf[tid] = cv * sigmoid_(cv); }
          __syncthreads();
          f32x4 a0 = {0.f, 0.f, 0.f, 0.f}, a1 = a0, a2 = a0, a3 = a0, a4 = a0; const float* wp = mw + (size_t)(ks * 64) * 12288 + col;
#pragma unroll 16
          for (int kk = 0; kk < 64; ++kk) { const f32x4 w = ldnt4(wp + (size_t)kk * 12288); a0 += ldsf[kk] * w; a1 += ldsf[64 + kk] * w; a2 += ldsf[128 + kk] * w; a3 += ldsf[192 + kk] * w; a4 += ldsf[256 + kk] * w; }
          float* o = mp + (size_t)ks * 5 * 12288 + col; *(f32x4*)(o) = a0; *(f32x4*)(o + 12288) = a1; *(f32x4*)(o + 2 * 12288) = a2; *(f32x4*)(o + 3 * 12288) = a3; *(f32x4*)(o + 4 * 12288) = a4; }
      __syncthreads(); }
    { float* kt = (float*)(ws + WS_KTAB4);
      for (int id4 = blk * 512 + tid; id4 < 131072; id4 += nblk * 512) { const int pq = id4 >> 15, id = id4 & 32767; const int g = id >> 9, d = (id >> 8) & 1, h = (id >> 4) & 15, hp = id & 15;
          float acc[16];
#pragma unroll
          for (int l = 0; l < 16; ++l) acc[l] = 0.f;
          for (int p = pq * 16; p < pq * 16 + 16; ++p) { float lr, li, fre, fim; s5_lam(P, d, g, p, lr, li, fre, fim);
              const float br = P.in[22][((d * 64 + g) * 64 + p) * 16 + hp], bi = P.in[23][((d * 64 + g) * 64 + p) * 16 + hp];
              const float bbr = fre * br - fim * bi, bbi = fre * bi + fim * br;
              const float cr = P.in[24][((d * 64 + g) * 16 + h) * 64 + p], ci = P.in[25][((d * 64 + g) * 16 + h) * 64 + p];
              const float xr = cr * bbr - ci * bbi, xi = cr * bbi + ci * bbr; float er = 1.f, ei = 0.f;
#pragma unroll
              for (int l = 0; l < 16; ++l) { acc[l] += xr * er - xi * ei; const float nr = er * lr - ei * li; ei = er * li + ei * lr; er = nr; } }
#pragma unroll
          for (int l = 0; l < 16; ++l) kt[(size_t)pq * 524288 + ((g * 2 + d) * 16 + l) * 256 + h * 16 + hp] = acc[l]; } }
    { bf16_t* bt = (bf16_t*)(ws + WS_BT_S5);
      for (int id = blk * 512 + tid; id < 131072; id += nblk * 512) { const int g = id >> 11, d = (id >> 10) & 1, p = (id >> 4) & 63, hp = id & 15;
          float lr, li, fre, fim; s5_lam(P, d, g, p, lr, li, fre, fim);
          const float br = P.in[22][((d * 64 + g) * 64 + p) * 16 + hp], bi = P.in[23][((d * 64 + g) * 64 + p) * 16 + hp];
          float vr = fre * br - fim * bi, vi = fre * bi + fim * br;
          bf16_t* rowr = bt + ((size_t)g * 256 + d * 128 + p) * 256; bf16_t* rowi = rowr + 64 * 256;
          for (int e = 0; e < 16; ++e) { const int tau = d ? e : 15 - e; rowr[tau * 16 + hp] = f2bf(vr); rowi[tau * 16 + hp] = f2bf(vi);
              const float nr = vr * lr - vi * li; vi = vr * li + vi * lr; vr = nr; } } }
    { bf16_t* tc = (bf16_t*)(ws + WS_TC_S5);
      for (int id = blk * 512 + tid; id < 131072; id += nblk * 512) { const int g = id >> 11, d = (id >> 10) & 1, h = (id >> 6) & 15, p = id & 63;
          float lr, li, fre, fim; s5_lam(P, d, g, p, lr, li, fre, fim);
          const float cr = P.in[24][((d * 64 + g) * 16 + h) * 64 + p], ci = P.in[25][((d * 64 + g) * 16 + h) * 64 + p];
          float gr = cr * lr - ci * li, gi = cr * li + ci * lr;
          for (int e = 1; e <= 16; ++e) { const int t = d ? 16 - e : e - 1; bf16_t* row = tc + ((size_t)g * 256 + t * 16 + h) * 512 + 256 + d * 128 + p;
              row[0] = f2bf(gr); row[64] = f2bf(-gi);
              const float nr = gr * lr - gi * li; gi = gr * li + gi * lr; gr = nr; } } }
}

__device__ void phase0b(const Params& P, const int tid) {
    const int nblk = gridDim.x, blk = blockIdx.x; unsigned char* ws = P.ws;
    { const float* mp = (const float*)(ws + WS_MODPART2); float* mv = (float*)(ws + WS_MODV);
      for (int id = blk * 512 + tid; id < 5 * 12288; id += nblk * 512) { const int col = id % 12288; float a = P.in[5][col];
#pragma unroll 8
          for (int ks = 0; ks < 32; ++ks) a += mp[(size_t)ks * 5 * 12288 + id];
          mv[id] = a; } }
    { const float* kt = (const float*)(ws + WS_KTAB4); bf16_t* tc = (bf16_t*)(ws + WS_TC_S5); const float* dd = P.in[26];
      for (int id = blk * 512 + tid; id < 64 * 65536; id += nblk * 512) { const int g = id >> 16, n = (id >> 8) & 255, k = id & 255; const int t = n >> 4, h = n & 15, tau = k >> 4, hp = k & 15;
          float v = 0.f;
          if (tau <= t) { const float* q = kt + ((g * 2 + 0) * 16 + (t - tau)) * 256 + h * 16 + hp; v += (q[0] + q[524288]) + (q[2 * 524288] + q[3 * 524288]); }
          if (tau >= t) { const float* q = kt + ((g * 2 + 1) * 16 + (tau - t)) * 256 + h * 16 + hp; v += (q[0] + q[524288]) + (q[2 * 524288] + q[3 * 524288]); }
          if (k == n) v += dd[g * 16 + h];
          tc[((size_t)g * 256 + n) * 512 + k] = f2bf(v); } }
}

__device__ void phase_norm_mod(const Params& P, int which, const int tid) {
    const int lane = tid & 63, gw = blockIdx.x * 8 + (tid >> 6), nw = gridDim.x * 8;
    const float* mv = (const float*)(P.ws + WS_MODV);
    const float* gam = P.in[which == 0 ? 6 : 30];
    bf16_t* dst = (bf16_t*)(P.ws + (which == 0 ? WS_HX : WS_HX2));
    f32x4 gv[8];
#pragma unroll
    for (int i = 0; i < 8; ++i) gv[i] = *(const f32x4*)(gam + lane * 4 + 256 * i);
    if (which == 0) {
#pragma unroll 2
        for (int row = gw; row < MT; row += nw) {
            const float* src; int mrow;
            { const int b = row / TP, tp = row - b * TP; if (tp < TCX) { src = P.in[2] + (size_t)(b * TCX + tp) * D; mrow = 4; } else { src = P.in[0] + (size_t)(b * T + tp - TCX) * D; mrow = b; } }
            const float* sh = mv + (size_t)mrow * 12288; const float* sc = sh + 2048;
            f32x4 v[8]; float ss = 0.f;
#pragma unroll
            for (int i = 0; i < 8; ++i) { v[i] = ldnt4(src + lane * 4 + 256 * i); ss += v[i][0] * v[i][0] + v[i][1] * v[i][1] + v[i][2] * v[i][2] + v[i][3] * v[i][3]; }
            ss = wave_sum(ss); const float rstd = rsqrtf(ss * (1.f / 2048.f) + 1e-6f);
#pragma unroll
            for (int i = 0; i < 8; ++i) { const int c = lane * 4 + 256 * i; const f32x4 scv = *(const f32x4*)(sc + c), shv = *(const f32x4*)(sh + c);
                float o[4];
#pragma unroll
                for (int j = 0; j < 4; ++j) o[j] = (v[i][j] * rstd * gv[i][j]) * (1.f + scv[j]) + shv[j];
                st4(dst + (size_t)row * D + c, o[0], o[1], o[2], o[3]); }
        }
    } else {
        for (int grp = gw; grp < ML / 8; grp += nw) {
            const int row0 = grp * 8, mrow = row0 / T;
            const float* sh = mv + (size_t)mrow * 12288 + 3 * 2048; const float* sc = sh + 2048;
            f32x4 gs[8], shv[8];
#pragma unroll
            for (int i = 0; i < 8; ++i) { const int c = lane * 4 + 256 * i; const f32x4 scv = *(const f32x4*)(sc + c); shv[i] = *(const f32x4*)(sh + c); gs[i] = gv[i] * (1.f + scv); }
#pragma unroll 2
            for (int r = 0; r < 8; ++r) { const int row = row0 + r; const float* src = P.out + (size_t)row * D;
                f32x4 v[8]; float ss = 0.f;
#pragma unroll
                for (int i = 0; i < 8; ++i) { v[i] = ldnt4(src + lane * 4 + 256 * i); ss += v[i][0] * v[i][0] + v[i][1] * v[i][1] + v[i][2] * v[i][2] + v[i][3] * v[i][3]; }
                ss = wave_sum(ss); const float rstd = rsqrtf(ss * (1.f / 2048.f) + 1e-6f);
#pragma unroll
                for (int i = 0; i < 8; ++i) { const int c = lane * 4 + 256 * i; const f32x4 o = v[i] * rstd * gs[i] + shv[i];
                    st4(dst + (size_t)row * D + c, o[0], o[1], o[2], o[3]); }
            }
        }
    }
}
__device__ void phase_final_norm(const Params& P, const int tid) {
    const int lane = tid & 63, gw = blockIdx.x * 8 + (tid >> 6), nw = gridDim.x * 8; const float* gam = P.in[35];
    f32x4 gv[8];
#pragma unroll
    for (int i = 0; i < 8; ++i) gv[i] = *(const f32x4*)(gam + lane * 4 + 256 * i);
#pragma unroll 2
    for (int row = gw; row < ML; row += nw) { float* src = P.out + (size_t)row * D; f32x4 v[8]; float ss = 0.f;
#pragma unroll
        for (int i = 0; i < 8; ++i) { v[i] = ldnt4(src + lane * 4 + 256 * i); ss += v[i][0] * v[i][0] + v[i][1] * v[i][1] + v[i][2] * v[i][2] + v[i][3] * v[i][3]; }
        ss = wave_sum(ss); const float rstd = rsqrtf(ss * (1.f / 2048.f) + 1e-6f);
#pragma unroll
        for (int i = 0; i < 8; ++i) { const int c = lane * 4 + 256 * i; stnt4(src + c, v[i] * rstd * gv[i]); } }
}

__device__ __forceinline__ int s5row(int b, int sc) { return sc >= 16 ? b * 256 + (sc - 16) : 1024 + b * 16 + sc; }
__device__ __forceinline__ void unpack8(const uint4 u, float (&o)[8]) { o[0] = bflo(u.x); o[1] = bfhi(u.x); o[2] = bflo(u.y); o[3] = bfhi(u.y); o[4] = bflo(u.z); o[5] = bfhi(u.z); o[6] = bflo(u.w); o[7] = bfhi(u.w); }
__device__ __forceinline__ void shift8(const uint4 pv, const uint4 cu, const uint4 nx, const float (&m0)[8], const float (&m1)[8], float (&q)[8]) {
    float a[8], b[8], c[8]; unpack8(pv, a); unpack8(cu, b); unpack8(nx, c);
#pragma unroll
    for (int e = 0; e < 8; ++e) q[e] = b[e] + m0[e] * (a[e] - b[e]) + m1[e] * (c[e] - b[e]);
}
__device__ __forceinline__ void ldc8(const float* p, float (&o)[8]) { const f32x4 a = *(const f32x4*)p, b = *(const f32x4*)(p + 4); o[0] = a[0]; o[1] = a[1]; o[2] = a[2]; o[3] = a[3]; o[4] = b[0]; o[5] = b[1]; o[6] = b[2]; o[7] = b[3]; }

__device__ void phase_prep(const Params& P, const int tid) {
    const int lane = tid & 63, gw = blockIdx.x * 8 + (tid >> 6), nw = gridDim.x * 8;
    const bf16_t* Pb = (const bf16_t*)(P.ws + WS_P); unsigned char* dob = (unsigned char*)P.out;
    bf16_t* Rr = (bf16_t*)(dob + DO_R); bf16_t* Kr = (bf16_t*)(dob + DO_K); bf16_t* KKr = (bf16_t*)(dob + DO_KK); bf16_t* As = (bf16_t*)(dob + DO_ASMALL);
    bf16_t* Vr = (bf16_t*)(P.ws + WS_V); bf16_t* A2 = (bf16_t*)(P.ws + WS_A2); float* bonus = (float*)(P.ws + WS_BONUS);
    const float* mu = P.in[8]; const float* k_k = P.in[14]; const float* r_k = P.in[16];
    const uint4 z4 = make_uint4(0u, 0u, 0u, 0u);
    constexpr int NFULL = 6144, NITEM = NFULL + 2 * ((MT / 8) * 3 - NFULL);
    for (int item = gw; item < NITEM; item += nw) {
        int run, sect, j0 = 0, nj = 8;
        if (item < NFULL) { run = item / 3; sect = item - run * 3; } else { const int hx_ = item - NFULL, it_ = NFULL + (hx_ >> 1); run = it_ / 3; sect = it_ - run * 3; j0 = (hx_ & 1) * 4; nj = 4; }
        const int R0 = run * 8 + j0;
        const int b = R0 / TP, tp0 = R0 - b * TP;
        const int ti0 = tp0 < TCX ? tp0 : ((tp0 - TCX) & 63), rowlen = tp0 < TCX ? TCX : 64;
        const bf16_t* pr0 = Pb + (size_t)R0 * NINP;
        if (sect < 2) {
            const int col = sect * 512 + lane * 8, head = sect * 8 + (lane >> 3), ch0 = (lane & 7) * 8;
            float mr0[8], mr1[8], mk0[8], mk1[8], mv0[8], mv1[8], kkc[8], rkc[8];
            ldc8(mu + col, mr0); ldc8(mu + RIN + col, mr1); ldc8(mu + 1024 + col, mk0); ldc8(mu + RIN + 1024 + col, mk1); ldc8(mu + 2048 + col, mv0); ldc8(mu + RIN + 2048 + col, mv1);
            ldc8(k_k + col, kkc); ldc8(r_k + col, rkc);
            uint4 pr_ = z4, pk_ = z4, pv_ = z4, cr_, ck_, cv_;
            if (ti0 > 0) { pr_ = ldnt16(pr0 - NINP + col); pk_ = ldnt16(pr0 - NINP + 1024 + col); pv_ = ldnt16(pr0 - NINP + 2048 + col); }
            cr_ = ldnt16(pr0 + col); ck_ = ldnt16(pr0 + 1024 + col); cv_ = ldnt16(pr0 + 2048 + col);
#pragma unroll 2
            for (int j = 0; j < nj; ++j) {
                const bf16_t* prn = pr0 + (size_t)(j + 1) * NINP; uint4 nr_ = z4, nk_ = z4, nv_ = z4;
                if (ti0 + j + 1 < rowlen) { nr_ = ldnt16(prn + col); nk_ = ldnt16(prn + 1024 + col); nv_ = ldnt16(prn + 2048 + col); }
                float r8[8], k8[8], v8[8], kk8[8]; shift8(pr_, cr_, nr_, mr0, mr1, r8); shift8(pk_, ck_, nk_, mk0, mk1, k8); shift8(pv_, cv_, nv_, mv0, mv1, v8);
                float ss = 0.f, bon = 0.f;
#pragma unroll
                for (int e = 0; e < 8; ++e) { kk8[e] = k8[e] * kkc[e]; ss += kk8[e] * kk8[e]; bon += r8[e] * k8[e] * rkc[e]; }
                ss += __shfl_xor(ss, 1, 64); ss += __shfl_xor(ss, 2, 64); ss += __shfl_xor(ss, 4, 64);
                bon += __shfl_xor(bon, 1, 64); bon += __shfl_xor(bon, 2, 64); bon += __shfl_xor(bon, 4, 64);
                const float inv = 1.f / fmaxf(sqrtf(ss), 1e-12f);
#pragma unroll
                for (int e = 0; e < 8; ++e) kk8[e] *= inv;
                const size_t idx = ((size_t)(b * 16 + head) * TP + tp0 + j) * 64 + ch0;
                st8(Rr + idx, r8); st8(Kr + idx, k8); st8(Vr + idx, v8); st8(KKr + idx, kk8);
                if ((lane & 7) == 0) bonus[(size_t)(R0 + j) * 16 + head] = bon;
                pr_ = cr_; pk_ = ck_; pv_ = cv_; cr_ = nr_; ck_ = nk_; cv_ = nv_;
            }
        } else {
            const int c0 = 3072 + (lane < 52 ? lane : 0) * 8;
            float m0[8], m1[8]; ldc8(mu + c0, m0); ldc8(mu + RIN + c0, m1);
            int dc, act;
            if (lane >= 52) { dc = 416 + (lane - 52) * 8; act = 3; } else if (c0 < 3232) { dc = 256 + (c0 - 3072); act = 0; } else if (c0 < 3360) { dc = c0 - 3232; act = 1; } else { dc = 128 + (c0 - 3360); act = 2; }
            uint4 pq_ = z4, cq_;
            if (ti0 > 0) pq_ = ldnt16(pr0 - NINP + c0);
            cq_ = ldnt16(pr0 + c0);
#pragma unroll 2
            for (int j = 0; j < nj; ++j) {
                const bf16_t* prc = pr0 + (size_t)j * NINP; uint4 nq_ = z4;
                if (ti0 + j + 1 < rowlen) nq_ = ldnt16(prc + NINP + c0);
                const uint4 u0 = ldnt16(prc + RIN + lane * 8), u1 = *(const uint4*)(prc + RIN + 512 + lane * 8);
                float q[8]; shift8(pq_, cq_, nq_, m0, m1, q);
#pragma unroll
                for (int e = 0; e < 8; ++e) q[e] = act == 0 ? sigmoid_(q[e]) : act == 1 ? tanh_(q[e]) : act == 2 ? q[e] : 0.f;
                st8(As + (size_t)(R0 + j) * 512 + dc, q);
                const int tp = tp0 + j;
                { const int c = lane * 8, gidx = c >> 4, hp0 = c & 15; *(uint4*)(A2 + ((size_t)gidx * 1280 + s5row(b, tp >> 4)) * 512 + (tp & 15) * 16 + hp0) = u0; }
                { const int c = lane * 8 + 512, gidx = c >> 4, hp0 = c & 15; *(uint4*)(A2 + ((size_t)gidx * 1280 + s5row(b, tp >> 4)) * 512 + (tp & 15) * 16 + hp0) = u1; }
                pq_ = cq_; cq_ = nq_;
            }
        }
    }
}

__device__ void phase_post(const Params& P, const int tid) {
    const int lane = tid & 63, gw = blockIdx.x * 8 + (tid >> 6), nw = gridDim.x * 8;
    const bf16_t* YF = (const bf16_t*)(P.ws + WS_YF); const bf16_t* YB = (const bf16_t*)(P.ws + WS_YB); const bf16_t* Vr = (const bf16_t*)(P.ws + WS_V);
    const bf16_t* G = (const bf16_t*)(P.ws + WS_G); const float* bonus = (const float*)(P.ws + WS_BONUS); bf16_t* O = (bf16_t*)(P.ws + WS_O);
    const float* lw = P.in[17]; const float* lb = P.in[18];
#pragma unroll 2
    for (int Rl = gw; Rl < ML; Rl += nw) { const int b = Rl / T, t = Rl - b * T; const size_t R = (size_t)b * TP + TCX + t;
#pragma unroll 1
        for (int half = 0; half < 2; ++half) { const int head = half * 8 + (lane >> 3), ch0 = (lane & 7) * 8, c = head * 64 + ch0;
            float yf[8], yb[8], v8[8], g8[8]; ld8nt(YF + (size_t)Rl * 1024 + c, yf); ld8nt(YB + (size_t)Rl * 1024 + c, yb);
            ld8(Vr + ((size_t)(b * 16 + head) * TP + TCX + t) * 64 + ch0, v8); ld8nt(G + R * 1024 + c, g8);
            float s = 0.f;
#pragma unroll
            for (int e = 0; e < 8; ++e) { yf[e] += yb[e]; s += yf[e]; }
            s += __shfl_xor(s, 1, 64); s += __shfl_xor(s, 2, 64); s += __shfl_xor(s, 4, 64); const float mean = s * (1.f / 64.f);
            float vs = 0.f;
#pragma unroll
            for (int e = 0; e < 8; ++e) { yf[e] -= mean; vs += yf[e] * yf[e]; }
            vs += __shfl_xor(vs, 1, 64); vs += __shfl_xor(vs, 2, 64); vs += __shfl_xor(vs, 4, 64); const float rstd = rsqrtf(vs * (1.f / 64.f) + 64e-5f);
            const float bon = bonus[R * 16 + head]; float o[8];
#pragma unroll
            for (int e = 0; e < 8; ++e) o[e] = (yf[e] * rstd * lw[c + e] + lb[c + e] + bon * v8[e]) * g8[e];
            st8(O + (size_t)Rl * 2048 + c, o); }
    }
}

__device__ void phase_s5_scan(const Params& P, const int tid) {
    if (tid >= 128) return;
    const float* W = (const float*)(P.ws + WS_W); bf16_t* A2 = (bf16_t*)(P.ws + WS_A2);
    for (int gid = blockIdx.x * 128 + tid; gid < 32768; gid += gridDim.x * 128) {
        const int p = gid & 63, d = (gid >> 6) & 1, g = (gid >> 7) & 63, b = gid >> 13;
        const float dt = expf(P.in[21][d * 64 + g]); const float are = P.in[19][(d * 64 + g) * 64 + p], aim = P.in[20][(d * 64 + g) * 64 + p];
        const float m16 = expf(16.f * are * dt); float c, s; cis_(16.f * aim * dt, c, s); const float lr = m16 * c, li = m16 * s;
        float sr = 0.f, si = 0.f;
        const size_t rowbase = (size_t)g * 1280;
        for (int n0 = 0; n0 < 272; n0 += 34) { float wr_[34], wi_[34]; int sidx[34];
#pragma unroll
            for (int u = 0; u < 34; ++u) { const int n = n0 + u; const int sc = d ? (n < 16 ? 15 - n : 287 - n) : n; sidx[u] = s5row(b, sc);
                const float* wp = W + (rowbase + sidx[u]) * 256 + d * 128 + p; wr_[u] = wp[0]; wi_[u] = wp[64]; }
#pragma unroll
            for (int u = 0; u < 34; ++u) { bf16_t* sp = A2 + (rowbase + sidx[u]) * 512 + 256 + d * 128 + p; sp[0] = f2bf(sr); sp[64] = f2bf(si);
                const float nr = lr * sr - li * si + wr_[u]; si = lr * si + li * sr + wi_[u]; sr = nr; } }
    }
}

typedef unsigned u32x4 __attribute__((ext_vector_type(4)));
__device__ void phase_rwkv_scan(const Params& P, unsigned char* lds, const int tid) {
    constexpr int BLK = 272, SLOT = 12800, O_W1 = 0, O_RR = 2176, O_BK = 4352, O_MAK = 8448, O_PP = 9472, O_GAM = 10496, O_VT = 10752, O_TI = 11776, NSLOT = 7, O_SCR = NSLOT * SLOT, SCRW = 6400, O_FLAG = O_SCR + 6 * SCRW;
    const int wave = __builtin_amdgcn_readfirstlane(tid >> 6), lane = tid & 63;
    unsigned char* dob = (unsigned char*)P.out;
    const bf16_t* Rr = (const bf16_t*)(dob + DO_R); const bf16_t* Kr = (const bf16_t*)(dob + DO_K); const bf16_t* KKr = (const bf16_t*)(dob + DO_KK); const bf16_t* Vr = (const bf16_t*)(P.ws + WS_V);
    int* flag = (int*)(lds + O_FLAG); int* done = flag + 8;
    for (int jb = blockIdx.x; jb < 256; jb += gridDim.x) {
        const int job = ((jb >> 4) << 4) | ((jb & 7) << 1) | ((jb >> 3) & 1);
        const int half = job & 1, d = (job >> 1) & 1, bh = job >> 2, b = bh >> 4, h = bh & 15;
        const bf16_t* NL = (const bf16_t*)(P.ws + (d ? WS_NLDB : WS_NLDF)); const bf16_t* AA = (const bf16_t*)(P.ws + (d ? WS_AB : WS_AF));
        bf16_t* Y = (bf16_t*)(P.ws + (d ? WS_YB : WS_YF));
        const size_t base = (size_t)bh * TP * 64;
#define T0(c) (d == 0 ? 16 * (c) : ((c) < 16 ? 240 - 16 * (c) : 4592 - 16 * (c)))
        __syncthreads();
        if (tid < NSLOT) flag[tid] = -1;
        if (tid < 2) done[tid] = 0;
        __syncthreads();
        if (wave < 2) {
            const int cw = wave, i16 = lane & 15, q = lane >> 4;
            f32x4 S0 = {0.f, 0.f, 0.f, 0.f}, S1 = S0, S2 = S0, S3 = S0;
            const f32x4 zero4 = {0.f, 0.f, 0.f, 0.f};
            for (int c = 0; c < 272; ++c) {
                const int slot = c % NSLOT; const unsigned char* sb = lds + slot * SLOT;
                while (__builtin_amdgcn_readfirstlane(__hip_atomic_load(flag + slot, __ATOMIC_ACQUIRE, __HIP_MEMORY_SCOPE_WORKGROUP)) != c) __builtin_amdgcn_s_sleep(1);
                const int fo = (q * 16 + i16) * 16;
                const int fp = q * BLK + i16 * 16;
                const bf16x8 w10 = *(const bf16x8*)(sb + O_W1 + fp), w11 = *(const bf16x8*)(sb + O_W1 + 4 * BLK + fp);
                const bf16x8 rr0 = *(const bf16x8*)(sb + O_RR + fp), rr1 = *(const bf16x8*)(sb + O_RR + 4 * BLK + fp);
                const bf16x8 bk0 = *(const bf16x8*)(sb + O_BK + fo), bk1 = *(const bf16x8*)(sb + O_BK + 1024 + fo), bk2 = *(const bf16x8*)(sb + O_BK + 2048 + fo), bk3 = *(const bf16x8*)(sb + O_BK + 3072 + fo);
                const bf16x8 mak = *(const bf16x8*)(sb + O_MAK + fo), pp = *(const bf16x8*)(sb + O_PP + fo), ti = *(const bf16x8*)(sb + O_TI + fo);
                const f32x4 g0 = *(const f32x4*)(sb + O_GAM + (4 * q) * 4), g1 = *(const f32x4*)(sb + O_GAM + (16 + 4 * q) * 4), g2 = *(const f32x4*)(sb + O_GAM + (32 + 4 * q) * 4), g3 = *(const f32x4*)(sb + O_GAM + (48 + 4 * q) * 4);
                const uint2 vt = *(const uint2*)(sb + O_VT + ((cw * 4 + q) * 16 + i16) * 8);
                asm volatile("s_waitcnt lgkmcnt(0)" ::: "memory");
                __builtin_amdgcn_fence(__ATOMIC_RELEASE, "workgroup");
                if (lane == 0) __hip_atomic_store(done + cw, c + 1, __ATOMIC_RELAXED, __HIP_MEMORY_SCOPE_WORKGROUP);
                const bf16x8 sb0 = (bf16x8)(u32x4){cvt_pk_bf16(S0[0], S0[1]), cvt_pk_bf16(S0[2], S0[3]), cvt_pk_bf16(S1[0], S1[1]), cvt_pk_bf16(S1[2], S1[3])};
                const bf16x8 sb1 = (bf16x8)(u32x4){cvt_pk_bf16(S2[0], S2[1]), cvt_pk_bf16(S2[2], S2[3]), cvt_pk_bf16(S3[0], S3[1]), cvt_pk_bf16(S3[2], S3[3])};
                const bf16x8 uv0 = (bf16x8)(u32x4){0u, 0u, vt.x, vt.y};
                f32x4 U = __builtin_amdgcn_mfma_f32_16x16x32_bf16(w10, sb0, zero4, 0, 0, 0);
                U = __builtin_amdgcn_mfma_f32_16x16x32_bf16(w11, sb1, U, 0, 0, 0);
                U = __builtin_amdgcn_mfma_f32_16x16x32_bf16(mak, uv0, U, 0, 0, 0);
                { const bf16x8 xv = (bf16x8)(u32x4){cvt_pk_bf16(U[0], U[1]), cvt_pk_bf16(U[2], U[3]), 0u, 0u}; U = __builtin_amdgcn_mfma_f32_16x16x32_bf16(ti, xv, zero4, 0, 0, 0); }
                f32x4 Yv = __builtin_amdgcn_mfma_f32_16x16x32_bf16(rr0, sb0, zero4, 0, 0, 0);
                Yv = __builtin_amdgcn_mfma_f32_16x16x32_bf16(rr1, sb1, Yv, 0, 0, 0);
                const bf16x8 uv = (bf16x8)(u32x4){cvt_pk_bf16(U[0], U[1]), cvt_pk_bf16(U[2], U[3]), vt.x, vt.y};
                Yv = __builtin_amdgcn_mfma_f32_16x16x32_bf16(pp, uv, Yv, 0, 0, 0);
                S0 = __builtin_amdgcn_mfma_f32_16x16x32_bf16(bk0, uv, S0, 0, 0, 0);
                S1 = __builtin_amdgcn_mfma_f32_16x16x32_bf16(bk1, uv, S1, 0, 0, 0);
                S2 = __builtin_amdgcn_mfma_f32_16x16x32_bf16(bk2, uv, S2, 0, 0, 0);
                S3 = __builtin_amdgcn_mfma_f32_16x16x32_bf16(bk3, uv, S3, 0, 0, 0);
                S0 *= g0; S1 *= g1; S2 *= g2; S3 *= g3;
                if (c >= 16) { const int t0 = T0(c);
#pragma unroll
                    for (int e = 0; e < 4; ++e) { const int t = 4 * q + e, tp = t0 + (d ? 15 - t : t);
                        Y[(size_t)(b * T + tp - TCX) * 1024 + h * 64 + half * 32 + cw * 16 + i16] = f2bf(Yv[e]); } }
            }
        } else {
#define T0D(c) (DD == 0 ? 16 * (c) : ((c) < 16 ? 240 - 16 * (c) : 4592 - 16 * (c)))
            auto producer = [&](auto dc) {
                constexpr int DD = decltype(dc)::value;
            const int pw = wave - 2, k = lane, m4 = k >> 4, i16 = lane & 15, q = lane >> 4;
            const int arr_off = ((m4 >> 1) * 4 + ((k >> 2) & 3)) * BLK + ((m4 & 1) * 4 + (k & 3)) * 2;
            unsigned char* scr = lds + O_SCR + pw * SCRW;
            float* nabf = (float*)(scr + 4352); float* nakf = (float*)(scr + 5376);
            const float kac = P.in[15][h * 64 + k];
            const int vl = lane & 31, th = lane >> 5;
            float nl[16], kq[16], aa[16], kr[16], rr[16], vv[8];
#define PLOAD(cc) do { const size_t o_ = base + (size_t)T0D(cc) * 64 + k; const bf16_t* pN = NL + o_; const bf16_t* pQ = KKr + o_; const bf16_t* pA = AA + o_; const bf16_t* pK = Kr + o_; const bf16_t* pR = Rr + o_; \
                const bf16_t* pV = Vr + base + (size_t)T0D(cc) * 64 + half * 32 + vl + (DD ? (15 - th * 8) * 64 : th * 8 * 64); \
                _Pragma("unroll") for (int i = 0; i < 16; ++i) { constexpr int dummy_ = 0; const int ofs = (DD ? 15 - i : i) * 64 + dummy_; \
                    nl[i] = bf2f(pN[ofs]); kq[i] = bf2f(pQ[ofs]); aa[i] = bf2f(pA[ofs]); kr[i] = bf2f(pK[ofs]); rr[i] = bf2f(pR[ofs]); } \
                _Pragma("unroll") for (int u = 0; u < 8; ++u) vv[u] = bf2f(pV[(DD ? -u : u) * 64]); } while (0)
            PLOAD(pw);
            for (int c = pw; c < 272; c += 6) {
                const int slot = c % NSLOT; unsigned char* sb = lds + slot * SLOT;
                for (;;) { const int d0 = __hip_atomic_load(done, __ATOMIC_ACQUIRE, __HIP_MEMORY_SCOPE_WORKGROUP), d1 = __hip_atomic_load(done + 1, __ATOMIC_ACQUIRE, __HIP_MEMORY_SCOPE_WORKGROUP);
                    if (__builtin_amdgcn_readfirstlane(d0 < d1 ? d0 : d1) >= c - 6) break; __builtin_amdgcn_s_sleep(1); }
                float al[16], be4[4], ka4[4]; float cs = 0.f, gp = 1.f;
#pragma unroll
                for (int i = 0; i < 16; ++i) { cs += nl[i]; const float g = __expf(-cs), ig = __expf(cs);
                    al[i] = gp * kq[i]; const float be = kq[i] * aa[i] * ig, ka = kr[i] * (1.f + (aa[i] - 1.f) * kac) * ig, rh = g * rr[i]; gp = g;
                    *(bf16_t*)(sb + O_W1 + arr_off + i * 16) = f2bf(al[i]); *(bf16_t*)(sb + O_RR + arr_off + i * 16) = f2bf(rh);
                    *(bf16_t*)(scr + arr_off + i * 16) = f2bf(be); *(bf16_t*)(scr + 2176 + arr_off + i * 16) = f2bf(ka);
                    be4[i & 3] = -be; ka4[i & 3] = ka;
                    if ((i & 3) == 3) { uint4 u; u.x = cvt_pk_bf16(be4[0], be4[1]); u.y = cvt_pk_bf16(be4[2], be4[3]); u.z = cvt_pk_bf16(ka4[0], ka4[1]); u.w = cvt_pk_bf16(ka4[2], ka4[3]);
                        *(uint4*)(sb + O_BK + ((m4 * 4 + (i >> 2)) * 16 + (k & 15)) * 16) = u; } }
                *(float*)(sb + O_GAM + k * 4) = gp;
#pragma unroll
                for (int u = 0; u < 8; ++u) { const int i = th * 8 + u; *(bf16_t*)(sb + O_VT + (((vl >> 4) * 4 + (i >> 2)) * 16 + (vl & 15)) * 8 + (i & 3) * 2) = f2bf(vv[u]); }
                if (c + 6 < 272) PLOAD(c + 6);
                const int fo = (q * 16 + i16) * 16;
                const int fp = q * BLK + i16 * 16;
                const bf16x8 al0 = *(const bf16x8*)(sb + O_W1 + fp), al1 = *(const bf16x8*)(sb + O_W1 + 4 * BLK + fp), rh0 = *(const bf16x8*)(sb + O_RR + fp), rh1 = *(const bf16x8*)(sb + O_RR + 4 * BLK + fp);
                const bf16x8 be0 = *(const bf16x8*)(scr + fp), be1 = *(const bf16x8*)(scr + 4 * BLK + fp), ka0 = *(const bf16x8*)(scr + 2176 + fp), ka1 = *(const bf16x8*)(scr + 2176 + 4 * BLK + fp);
                const f32x4 z4 = {0.f, 0.f, 0.f, 0.f};
                f32x4 nab = __builtin_amdgcn_mfma_f32_16x16x32_bf16(al0, be0, z4, 0, 0, 0); nab = __builtin_amdgcn_mfma_f32_16x16x32_bf16(al1, be1, nab, 0, 0, 0);
                f32x4 nak = __builtin_amdgcn_mfma_f32_16x16x32_bf16(al0, ka0, z4, 0, 0, 0); nak = __builtin_amdgcn_mfma_f32_16x16x32_bf16(al1, ka1, nak, 0, 0, 0);
                f32x4 prb = __builtin_amdgcn_mfma_f32_16x16x32_bf16(rh0, be0, z4, 0, 0, 0); prb = __builtin_amdgcn_mfma_f32_16x16x32_bf16(rh1, be1, prb, 0, 0, 0);
                f32x4 prk = __builtin_amdgcn_mfma_f32_16x16x32_bf16(rh0, ka0, z4, 0, 0, 0); prk = __builtin_amdgcn_mfma_f32_16x16x32_bf16(rh1, ka1, prk, 0, 0, 0);
#pragma unroll
                for (int e = 0; e < 4; ++e) { const int t = 4 * q + e;
                    nabf[t * 16 + i16] = (i16 < t) ? nab[e] : 0.f;
                    unsigned char* ppp = sb + O_PP + (((i16 >> 2) * 16 + t) * 8 + (i16 & 3)) * 2;
                    *(bf16_t*)(ppp) = f2bf((i16 <= t) ? -prb[e] : 0.f); *(bf16_t*)(ppp + 8) = f2bf((i16 <= t) ? prk[e] : 0.f);
                    unsigned char* mkp = sb + O_MAK + (((i16 >> 2) * 16 + t) * 8 + (i16 & 3)) * 2;
                    *(bf16_t*)(mkp) = 0; *(bf16_t*)(mkp + 8) = f2bf((i16 < t) ? nak[e] : 0.f); }
                float xr[16]; xr[0] = (i16 == 0) ? 1.f : 0.f;
                unsigned char* tip = sb + O_TI + (((i16 >> 2) * 16) * 8 + (i16 & 3)) * 2;
                if (lane < 16) { *(bf16_t*)(tip) = f2bf(xr[0]); *(bf16_t*)(tip + 8) = 0; }
#pragma unroll
                for (int t = 1; t < 16; ++t) {
                    float nrow[16];
#pragma unroll
                    for (int g4 = 0; g4 < 4; ++g4) if (g4 * 4 < t) { const f32x4 v4 = *(const f32x4*)(nabf + t * 16 + g4 * 4); nrow[g4 * 4] = v4[0]; nrow[g4 * 4 + 1] = v4[1]; nrow[g4 * 4 + 2] = v4[2]; nrow[g4 * 4 + 3] = v4[3]; }
                    float ax = (i16 == t) ? 1.f : 0.f;
#pragma unroll
                    for (int i = 0; i < t; ++i) ax -= nrow[i] * xr[i];
                    xr[t] = ax;
                    if (lane < 16) { *(bf16_t*)(tip + t * 16) = f2bf(ax); *(bf16_t*)(tip + t * 16 + 8) = 0; }
                }
                asm volatile("s_waitcnt lgkmcnt(0)" ::: "memory");
                __builtin_amdgcn_fence(__ATOMIC_RELEASE, "workgroup");
                if (lane == 0) __hip_atomic_store(flag + slot, c, __ATOMIC_RELAXED, __HIP_MEMORY_SCOPE_WORKGROUP);
            }
                    };
            if (d) producer(std::integral_constant<int, 1>{}); else producer(std::integral_constant<int, 0>{});
#undef T0D
        }
#undef PLOAD
#undef T0
    }
    __syncthreads();
}

#define XB_TMO      128
#define XB_XCNT(j)  (256  + 64 * (j))
#define XB_XSUB(j)  (1280 + 64 * (j))
#define XB_XGEN(j)  (2304 + 64 * (j))
#define XB_TOP      3328
#define XB_TOPGEN   3392
#define XCD_BAR_WORDS 3456
#define XB_SPIN_CAP (1u << 18)
__device__ __forceinline__ unsigned xb_ld(unsigned* p)              { return __hip_atomic_load(p, __ATOMIC_RELAXED, __HIP_MEMORY_SCOPE_AGENT); }
__device__ __forceinline__ unsigned xb_add(unsigned* p, unsigned v) { return __hip_atomic_fetch_add(p, v, __ATOMIC_RELAXED, __HIP_MEMORY_SCOPE_AGENT); }
__device__ __forceinline__ unsigned xb_xcc_id() { return (unsigned)__builtin_amdgcn_s_getreg((3 << 11) | 20) & 0xFu; }
#define XB_SPIN(cond, bar) do { unsigned _sp = 0; while (cond) { __builtin_amdgcn_s_sleep(1); \
    if ((++_sp & 255u) == 0u) { if (xb_ld(&(bar)[XB_TMO])) break; if (_sp > XB_SPIN_CAP) { atomicAdd(&(bar)[XB_TMO], 1u); break; } } } } while (0)
struct XcdBarrier { unsigned* bar; unsigned x; volatile LAS unsigned* st; };
__device__ __forceinline__ void xcd_barrier_complete(unsigned* bar, unsigned x, unsigned& nloc, unsigned& nx) {
    const unsigned G = gridDim.x;
    unsigned sum, cnt, mine, sp = 0u;
    for (;;) {
        sum = 0u; cnt = 0u; mine = 0u;
#pragma unroll
        for (unsigned j = 0; j < 16; ++j) { const unsigned c = xb_ld(&bar[XB_XCNT(j)]); sum += c; cnt += (c > 0u) ? 1u : 0u; mine = (j == x) ? c : mine; }
        if (sum == G) break;
        __builtin_amdgcn_s_sleep(1);
        if ((++sp & 255u) == 0u) { if (xb_ld(&bar[XB_TMO])) break; if (sp > XB_SPIN_CAP) { atomicAdd(&bar[XB_TMO], 1u); break; } }
    }
    nloc = mine > 0u ? mine : 1u; nx = cnt > 0u ? cnt : 1u;
}
__device__ __forceinline__ void xcd_barrier(const XcdBarrier& b, const int tid) {
    asm volatile("s_waitcnt vmcnt(0)" ::: "memory");
    __syncthreads();
    if (tid == 0) {
        unsigned* bar = b.bar;
        __builtin_amdgcn_s_waitcnt(0);
        unsigned nloc = b.st[0], nx = b.st[1];
        if (nloc == 0u) { xcd_barrier_complete(bar, b.x, nloc, nx); b.st[0] = nloc; b.st[1] = nx; }
        const unsigned old = xb_add(&bar[XB_XSUB(b.x)], 1u);
        const unsigned gen = old / nloc;
        if (old + 1u == (gen + 1u) * nloc) {
            __builtin_amdgcn_fence(__ATOMIC_RELEASE, "agent");
            asm volatile("s_waitcnt vmcnt(0)" ::: "memory");
            const unsigned og = xb_add(&bar[XB_TOP], 1u);
            const unsigned tg = og / nx;
            if (og + 1u == (tg + 1u) * nx) xb_add(&bar[XB_TOPGEN], 1u);
            else XB_SPIN(xb_ld(&bar[XB_TOPGEN]) == tg, bar);
            __builtin_amdgcn_fence(__ATOMIC_ACQUIRE, "agent");
            xb_add(&bar[XB_XGEN(b.x)], 1u);
            asm volatile("s_waitcnt vmcnt(0)" ::: "memory");
        } else {
            XB_SPIN(xb_ld(&bar[XB_XGEN(b.x)]) == gen, bar);
            __builtin_amdgcn_fence(__ATOMIC_ACQUIRE, "agent");
            asm volatile("s_waitcnt vmcnt(0)" ::: "memory");
        }
    }
    __syncthreads();
}

#ifndef MK_ONLY
#define MK_ONLY -1
#endif
#ifndef MK_REPMASK
#define MK_REPMASK 0x0
#endif
__global__ void __launch_bounds__(512) mk_fwd(Params P) {
    __builtin_assume(__builtin_amdgcn_workitem_id_y() == 0); __builtin_assume(__builtin_amdgcn_workitem_id_z() == 0);
    extern __shared__ __attribute__((aligned(16))) unsigned char shm[];
    cg::grid_group grid = cg::this_grid();
    LAS unsigned char* lds = (LAS unsigned char*)shm; float* ldsf = (float*)shm;
    unsigned char* ws = P.ws; unsigned char* dob = (unsigned char*)P.out;
    const int G = gridDim.x, c = blockIdx.x;
    const int wid_s = __builtin_amdgcn_readfirstlane((int)threadIdx.x >> 6);
#define PH_TID() ({ int l_; asm volatile("v_mbcnt_lo_u32_b32 %0, -1, 0\n\tv_mbcnt_hi_u32_b32 %0, -1, %0" : "=v"(l_)); wid_s * 64 + l_; })
    const float* mv = (const float*)(ws + WS_MODV);
#define EN(k) ((MK_ONLY < 0 || MK_ONLY == (k)) && P.ph_lo <= (k) && (k) < P.ph_hi)
    XcdBarrier xb; xb.bar = (unsigned*)(ws + WS_BAR); xb.x = xb_xcc_id(); xb.st = (volatile LAS unsigned*)(lds + 131072);
    if (P.ph_hi < 0) grid.sync();
    { const int t_ = PH_TID(); if (t_ < 2) xb.st[t_] = 0u; __syncthreads(); if (t_ == 0 && P.ph_hi - P.ph_lo > 1) (void)xb_add(&xb.bar[XB_XCNT(xb.x)], 1u); }
#define SYNC(k) do { if (P.ph_lo <= (k) && (k) + 1 < P.ph_hi) xcd_barrier(xb, PH_TID()); } while (0)
    if (EN(0)) for (int r_ = 0; r_ < ((MK_REPMASK >> 0) & 1) + 1; ++r_) { phase0(P, ldsf, PH_TID()); }
    SYNC(0);
    if (EN(1)) for (int r_ = 0; r_ < ((MK_REPMASK >> 1) & 1) + 1; ++r_) { phase0b(P, PH_TID()); }
    SYNC(1);
    if (EN(2)) for (int r_ = 0; r_ < ((MK_REPMASK >> 2) & 1) + 1; ++r_) { phase_norm_mod(P, 0, PH_TID()); }
    SYNC(2);
    if (EN(3)) for (int r_ = 0; r_ < ((MK_REPMASK >> 3) & 1) + 1; ++r_) { { pg8::StaticOrder S; S.init(MT, NINP, G, c); pg8::Gemm g{(const bf16_t*)(ws + WS_HX), (const bf16_t*)(ws + WS_WT_IN), 2048, 2048, 2048};
                  EpiStoreBf16 E{(bf16_t*)(ws + WS_P), NINP}; pg8::gemm_phase(lds, g, S, E, PH_TID()); } }
    SYNC(3);
    if (EN(4)) for (int r_ = 0; r_ < ((MK_REPMASK >> 4) & 1) + 1; ++r_) { phase_prep(P, PH_TID()); }
    SYNC(4);
    if (EN(5)) for (int r_ = 0; r_ < ((MK_REPMASK >> 5) & 1) + 1; ++r_) { {
            { pg8::GroupOrder S{G, c}; pg8::Gemm g{(const bf16_t*)(ws + WS_A2), (const bf16_t*)(ws + WS_BT_S5), 256, 512, 256}; EpiStoreF32 E{(float*)(ws + WS_W), 256}; pg8::gemm_phase(lds, g, S, E, PH_TID()); }
            { pg8::StaticOrder S; S.init(MT, 4096, G, (c + 128) % G);
              pg8::Gemm g{(const bf16_t*)(dob + DO_ASMALL), (const bf16_t*)(ws + WS_WT_WA), 256, 512, 256};
              EpiLoraWA E{(bf16_t*)(ws + WS_NLDF), (bf16_t*)(ws + WS_NLDB), (bf16_t*)(ws + WS_AF), (bf16_t*)(ws + WS_AB), P.in[9], P.in[11]}; pg8::gemm_phase(lds, g, S, E, PH_TID()); }
            { pg8::LatentOrder S{G, c}; pg8::Gemm g{(const bf16_t*)(dob + DO_ASMALL) + 256, (const bf16_t*)(ws + WS_WT_G), 256, 512, 256};
              EpiStoreBf16 E{(bf16_t*)(ws + WS_G), 1024}; pg8::gemm_phase(lds, g, S, E, PH_TID()); }
        } }
    SYNC(5);
    if (EN(6)) for (int r_ = 0; r_ < ((MK_REPMASK >> 6) & 1) + 1; ++r_) { { const int tid6 = PH_TID(); phase_s5_scan(P, tid6); phase_rwkv_scan(P, shm, tid6); } }
    SYNC(6);
    if (EN(7)) for (int r_ = 0; r_ < ((MK_REPMASK >> 7) & 1) + 1; ++r_) { {
            phase_post(P, PH_TID());
            { pg8::GroupOrder4 S{G, c}; pg8::Gemm g{(const bf16_t*)(ws + WS_A2), (const bf16_t*)(ws + WS_TC_S5), 512, 512, 512}; EpiS5Y E{(bf16_t*)(dob + DO_Z)}; pg8::gemm_phase(lds, g, S, E, PH_TID()); }
        } }
    SYNC(7);
    if (EN(8)) for (int r_ = 0; r_ < ((MK_REPMASK >> 8) & 1) + 1; ++r_) { { pg8::StaticOrder S; S.init(ML, 1024, G, c); pg8::Gemm g{(const bf16_t*)(dob + DO_Z), (const bf16_t*)(ws + WS_WT_GLU), 1024, 1024, 1024};
                  EpiGLU E{(const bf16_t*)(dob + DO_Z), (bf16_t*)(ws + WS_O), P.in[28]}; pg8::gemm_phase(lds, g, S, E, PH_TID()); } }
    SYNC(8);
    if (EN(9)) for (int r_ = 0; r_ < ((MK_REPMASK >> 9) & 1) + 1; ++r_) { { pg8::StaticOrder S; S.init(ML, 2048, G, c); pg8::Gemm g{(const bf16_t*)(ws + WS_O), (const bf16_t*)(ws + WS_WT_OUT), 2048, 2048, 2048};
                  EpiResid E{P.in[0], P.out, mv + 2 * 2048}; pg8::gemm_phase(lds, g, S, E, PH_TID()); } }
    SYNC(9);
    if (EN(10)) for (int r_ = 0; r_ < ((MK_REPMASK >> 10) & 1) + 1; ++r_) { { const int tid10 = PH_TID();
                 transpose_weight(P.in[31], 2 * DFF, 2 * DFF, 2048, 2 * DFF, 3, (bf16_t*)(ws + WS_WT_UP), tid10);
                 transpose_weight(P.in[34], 2048, 2048, DFF, 2048, 4, (bf16_t*)(ws + WS_WT_DOWN), tid10, 5632);
                 phase_norm_mod(P, 1, tid10); } }
    SYNC(10);
    if (EN(11)) for (int r_ = 0; r_ < ((MK_REPMASK >> 11) & 1) + 1; ++r_) { { pg8::StaticOrder S; S.init(ML, 2 * DFF, G, c); pg8::Gemm g{(const bf16_t*)(ws + WS_HX2), (const bf16_t*)(ws + WS_WT_UP), 2048, 2048, 2048};
                   EpiFFNUp E{(bf16_t*)(ws + WS_H), P.in[32], P.in[33]}; pg8::gemm_phase(lds, g, S, E, PH_TID()); } }
    SYNC(11);
    if (EN(12)) for (int r_ = 0; r_ < ((MK_REPMASK >> 12) & 1) + 1; ++r_) { { pg8::StaticOrder S; S.init(ML, 2048, G, c); pg8::Gemm g{(const bf16_t*)(ws + WS_H), (const bf16_t*)(ws + WS_WT_DOWN), DFF, DFF, DFF, 1};
                   EpiResid E{P.out, P.out, mv + 5 * 2048}; pg8::gemm_phase(lds, g, S, E, PH_TID()); } }
    SYNC(12);
    if (EN(13)) for (int r_ = 0; r_ < ((MK_REPMASK >> 13) & 1) + 1; ++r_) { phase_final_norm(P, PH_TID()); }
    SYNC(13);
}

#ifndef MK_PER_PHASE
#define MK_PER_PHASE 0
#endif
extern "C" void kernel_launch(void* const* d_in, const int* in_sizes, int n_in, void* d_out, int out_size, void* d_ws, size_t ws_size, hipStream_t stream) {
    static int grid = 0;
    if (grid == 0) {
        if (n_in != 36 || out_size != ML * D || ws_size < WS_NEED) { fprintf(stderr, "kernel_launch: unexpected shapes (n_in %d out %d ws %zu)\n", n_in, out_size, ws_size); grid = -1; return; }
        int dev = 0, cus = 0, per_cu = 0;
        hipGetDevice(&dev); hipDeviceGetAttribute(&cus, hipDeviceAttributeMultiprocessorCount, dev);
        hipFuncSetAttribute((const void*)mk_fwd, hipFuncAttributeMaxDynamicSharedMemorySize, LDS_BYTES);
        hipOccupancyMaxActiveBlocksPerMultiprocessor(&per_cu, (const void*)mk_fwd, 512, LDS_BYTES);
        if (per_cu < 1) { fprintf(stderr, "kernel_launch: occupancy query says %d blocks per CU\n", per_cu); per_cu = 1; }
        grid = cus;
        (void)hipGetLastError();
    }
    if (grid < 0) return;
    Params p{};
    for (int i = 0; i < 36; ++i) p.in[i] = (const float*)d_in[i];
    p.out = (float*)d_out; p.ws = (unsigned char*)d_ws;
#if MK_PER_PHASE
    for (int ph = 0; ph < 14; ++ph) { p.ph_lo = ph; p.ph_hi = ph + 1; hipLaunchKernelGGL(mk_fwd, dim3(grid), dim3(512), LDS_BYTES, stream, p); }
#else
    p.ph_lo = 0; p.ph_hi = 14;
    if (hipMemsetAsync((char*)d_ws + WS_BAR, 0, 3456 * sizeof(unsigned), stream) != hipSuccess) { fprintf(stderr, "kernel_launch: memset of the barrier words failed\n"); return; }
    void* args[] = {&p};
    hipError_t e = hipLaunchCooperativeKernel((const void*)mk_fwd, dim3(grid), dim3(512), args, LDS_BYTES, stream);
    if (e != hipSuccess) fprintf(stderr, "cooperative launch failed: %s (grid %d)\n", hipGetErrorString(e), grid);
#endif
}
```

```cpp
#include <hip/hip_runtime.h>
#include <hip/hip_cooperative_groups.h>
#include <cstdio>
#include <type_traits>
namespace cg = cooperative_groups;

#define LAS __attribute__((address_space(3)))
typedef unsigned short bf16_t;
typedef short bf16x8 __attribute__((ext_vector_type(8)));
typedef float f32x4 __attribute__((ext_vector_type(4)));

constexpr int D = 2048, NB = 4, T = 4096, TCX = 256, TP = 4352, MT = NB * TP, ML = NB * T;
constexpr int NIN = 4512, NINP = 4608, RIN = 3488, DFF = 5632;
constexpr int LDS_BYTES = 131072 + 16;
constexpr size_t MiB = 1048576;
constexpr size_t WS_BAR = 3 * MiB + 3 * MiB / 4;
constexpr size_t WS_MODPART = 0, WS_MODV = 2 * MiB, WS_BONUS = 2 * MiB + MiB / 2, WS_KTAB = 4 * MiB, WS_WT_IN = 6 * MiB, WS_WT_GLU = 24 * MiB,
                 WS_WT_OUT = 26 * MiB, WS_WT_WA = 34 * MiB, WS_WT_G = 36 * MiB, WS_BT_S5 = 37 * MiB, WS_TC_S5 = 45 * MiB;
constexpr size_t WS_MODPART2 = 64 * MiB, WS_KTAB4 = 72 * MiB;
constexpr size_t WS_B = 64 * MiB, WS_P = WS_B, WS_W = WS_B, WS_YF = WS_B + 80 * MiB, WS_YB = WS_B + 112 * MiB;
constexpr size_t WS_C = 217 * MiB, WS_HX = WS_C, WS_NLDF = WS_C, WS_NLDB = WS_C + 34 * MiB, WS_AF = WS_C + 68 * MiB, WS_AB = WS_C + 102 * MiB,
                 WS_V = WS_C + 136 * MiB, WS_A2 = WS_C + 170 * MiB, WS_G = WS_C + 250 * MiB, WS_O = WS_C;
constexpr size_t WS_H = 64 * MiB, WS_HX2 = 240 * MiB, WS_WT_UP = 304 * MiB, WS_WT_DOWN = 348 * MiB;
constexpr size_t WS_NEED = 512 * MiB;
constexpr size_t DO_R = 0, DO_K = 34 * MiB, DO_KK = 68 * MiB, DO_ASMALL = 102 * MiB, DO_Z = 0;

struct Params { const float* in[36]; float* out; unsigned char* ws; int ph_lo, ph_hi; };

typedef __bf16 bf16v2_t __attribute__((ext_vector_type(2)));
typedef float f32v2_t __attribute__((ext_vector_type(2)));
__device__ __forceinline__ unsigned cvt_pk_bf16(float lo, float hi) { const f32v2_t v = {lo, hi}; const bf16v2_t b = __builtin_convertvector(v, bf16v2_t); return __builtin_bit_cast(unsigned, b); }
__device__ __forceinline__ float bflo(unsigned u) { return __uint_as_float(u << 16); }
__device__ __forceinline__ float bfhi(unsigned u) { return __uint_as_float(u & 0xffff0000u); }
__device__ __forceinline__ float bf2f(bf16_t v) { return __uint_as_float(((unsigned)v) << 16); }
__device__ __forceinline__ bf16_t f2bf(float f) { return (bf16_t)(cvt_pk_bf16(f, 0.f) & 0xffffu); }
__device__ __forceinline__ void ld8(const bf16_t* p, float (&o)[8]) {
    const uint4 u = *(const uint4*)p;
    o[0] = bflo(u.x); o[1] = bfhi(u.x); o[2] = bflo(u.y); o[3] = bfhi(u.y); o[4] = bflo(u.z); o[5] = bfhi(u.z); o[6] = bflo(u.w); o[7] = bfhi(u.w);
}
__device__ __forceinline__ void ld8nt(const bf16_t* p, float (&o)[8]);
__device__ __forceinline__ void st8(bf16_t* p, const float (&v)[8]) {
    uint4 u; u.x = cvt_pk_bf16(v[0], v[1]); u.y = cvt_pk_bf16(v[2], v[3]); u.z = cvt_pk_bf16(v[4], v[5]); u.w = cvt_pk_bf16(v[6], v[7]); *(uint4*)p = u;
}
__device__ __forceinline__ void st4(bf16_t* p, float a, float b, float c, float d) { uint2 u; u.x = cvt_pk_bf16(a, b); u.y = cvt_pk_bf16(c, d); *(uint2*)p = u; }
typedef unsigned u32x4_nt __attribute__((ext_vector_type(4)));
__device__ __forceinline__ f32x4 ldnt4(const float* p) { return __builtin_nontemporal_load((const f32x4*)p); }
__device__ __forceinline__ void stnt4(float* p, f32x4 v) { __builtin_nontemporal_store(v, (f32x4*)p); }
__device__ __forceinline__ uint4 ldnt16(const bf16_t* p);
__device__ __forceinline__ uint4 ldnt16(const bf16_t* p) { const u32x4_nt v = __builtin_nontemporal_load((const u32x4_nt*)p); return make_uint4(v[0], v[1], v[2], v[3]); }
__device__ __forceinline__ void ld8nt(const bf16_t* p, float (&o)[8]) { const uint4 u = ldnt16(p); o[0] = bflo(u.x); o[1] = bfhi(u.x); o[2] = bflo(u.y); o[3] = bfhi(u.y); o[4] = bflo(u.z); o[5] = bfhi(u.z); o[6] = bflo(u.w); o[7] = bfhi(u.w); }
__device__ __forceinline__ float sigmoid_(float x) { return __builtin_amdgcn_rcpf(1.f + __expf(-x)); }
__device__ __forceinline__ float tanh_(float x) { return 1.f - 2.f * __builtin_amdgcn_rcpf(1.f + __expf(2.f * x)); }
__device__ __forceinline__ float gelu_(float x) { const float u = 1.5957691216f * (x + 0.044715f * x * x * x); return x * __builtin_amdgcn_rcpf(1.f + __expf(-u)); }
__device__ __forceinline__ void cis_(float ang, float& c, float& s) { float rev = ang * 0.15915494309f; rev -= rintf(rev); s = __builtin_amdgcn_sinf(rev); c = __builtin_amdgcn_cosf(rev); }
template <int CTRL> __device__ __forceinline__ float dpp_(float v) { return __int_as_float(__builtin_amdgcn_update_dpp(0, __float_as_int(v), CTRL, 0xF, 0xF, false)); }
__device__ __forceinline__ float reduce16(float x) { x += dpp_<0xB1>(x); x += dpp_<0x4E>(x); x += dpp_<0x141>(x); x += dpp_<0x140>(x); return x; }
__device__ __forceinline__ float wave_sum(float x) {
#pragma unroll
    for (int o = 32; o >= 1; o >>= 1) x += __shfl_xor(x, o, 64);
    return x;
}

namespace pg8 {
constexpr int BM = 256, BK = 64, HALF = 128, HTB = HALF * BK * 2, STAGE_BYTES = 8 * HTB, NXCD = 8, WGM = 8;
__host__ __device__ __forceinline__ int lds_byte(int r, int c) { const int st = (r >> 4) * 2 + (c >> 5), rr = r & 15, cc = c & 31, ob = rr * 64 + cc * 2; return st * 1024 + (ob ^ (((ob >> 9) & 1) << 5)); }
__host__ __device__ __forceinline__ void stage_rc(int b, int& R, int& C) { const int st = b / 1024, sb = b % 1024, swz = sb ^ (((sb >> 9) & 1) << 5); R = (st >> 1) * 16 + swz / 64; C = (st & 1) * 32 + (swz % 64) / 2; }
struct Unit { int pm, pn; };
struct Gemm { const bf16_t* A; const bf16_t* Bt; int K, lda, ldb; };
struct StaticOrder {
    int nM, nN, nwg, G, c;
    __device__ void init(int M, int N, int G_, int c_) { nM = M / BM; nN = N / BM; nwg = nM * nN; G = G_; c = c_; }
    __device__ bool next(int i, Unit& u) const {
        const long L = (long)i * G + c; if (L >= nwg) return false;
        int wgid = (int)L; { const int q = nwg / NXCD, r = nwg % NXCD, xcd = wgid % NXCD, off = wgid / NXCD; wgid = (xcd < r ? xcd * (q + 1) : r * (q + 1) + (xcd - r) * q) + off; }
        const int nig = WGM * nN, gid = wgid / nig, fm = gid * WGM, gsz = (nM - fm) < WGM ? (nM - fm) : WGM;
        u.pm = fm + ((wgid % nig) % gsz); u.pn = (wgid % nig) / gsz; return true;
    }
};
struct LatentOrder {
    int G, c;
    __device__ bool next(int i, Unit& u) const { const long L = (long)i * G + c; if (L >= 256) return false; const int pml = (int)L >> 2; u.pm = (pml >> 4) * 17 + 1 + (pml & 15); u.pn = (int)L & 3; return true; }
};
struct GroupOrder4 {
    int G, c;
    __device__ bool next(int i, Unit& u) const { const long L = (long)i * G + c; if (L >= 256) return false; u.pn = (int)L >> 2; u.pm = u.pn * 5 + ((int)L & 3); return true; }
};
struct GroupOrder {
    int G, c;
    __device__ bool next(int i, Unit& u) const { const long L = (long)i * G + c; if (L >= 320) return false; u.pm = (int)L; u.pn = (int)L / 5; return true; }
};

template <class Epi, class Sched>
__device__ __forceinline__ void gemm_phase(LAS unsigned char* lds, const Gemm g, const Sched& S, const Epi& E, const int tid) {
    const int wid = __builtin_amdgcn_readfirstlane(tid >> 6), lane = tid & 63, wr = wid >> 2, wc = wid & 3, fr = lane & 15, fq = lane >> 4;
    const int K = g.K, nt = K / BK;
    unsigned voffA[2], voffB[2];
#pragma unroll
    for (int i = 0; i < 2; ++i) { int R, C; stage_rc(tid * 16 + i * 8192, R, C); voffA[i] = (unsigned)(R * g.lda + C) * 2u; voffB[i] = (unsigned)(R * g.ldb + C) * 2u; }
    const size_t kstep = (size_t)(BK * 2);
    const size_t hstepA = (size_t)HALF * g.lda * 2, hstepB = (size_t)HALF * g.ldb * 2;
    const size_t tstepA = 2 * hstepA, tstepB = 2 * hstepB;
    const unsigned ldsw = (unsigned)wid * 1024u;
    const int aoff = lds_byte(wr * 64 + fr, fq * 8), boff = lds_byte(wc * 32 + fr, fq * 8);
#define PG8_SA(b, h) (((b) * 2 + (h)) * HTB)
#define PG8_SB(b, h) ((4 + (b) * 2 + (h)) * HTB)
#define PG8_STAGE(bufoff, gbase, voff) do { _Pragma("unroll") for (int _i = 0; _i < 2; ++_i) \
        __builtin_amdgcn_global_load_lds((const unsigned*)((const char*)(gbase) + (voff)[_i]), (LAS unsigned*)(lds + (bufoff) + ldsw + _i * 8192), 16, 0, 0); } while (0)
#define PG8_LDA(dst, b, h) do { _Pragma("unroll") for (int m = 0; m < 4; ++m) _Pragma("unroll") for (int k = 0; k < 2; ++k) dst[m][k] = *(const LAS bf16x8*)(lds + PG8_SA(b, h) + aoff + m * 2048 + k * 1024); } while (0)
#define PG8_LDB(dst, b, h) do { _Pragma("unroll") for (int n = 0; n < 2; ++n) _Pragma("unroll") for (int k = 0; k < 2; ++k) dst[n][k] = *(const LAS bf16x8*)(lds + PG8_SB(b, h) + boff + n * 2048 + k * 1024); } while (0)
#define PG8_MMA(ai, bj, At, Bt) do { __builtin_amdgcn_s_setprio(1); _Pragma("unroll") for (int m = 0; m < 4; ++m) _Pragma("unroll") for (int n = 0; n < 2; ++n) _Pragma("unroll") for (int k = 0; k < 2; ++k) \
        acc[ai][bj][m][n] = __builtin_amdgcn_mfma_f32_16x16x32_bf16(Bt[n][k], At[m][k], acc[ai][bj][m][n], 0, 0, 0); __builtin_amdgcn_s_setprio(0); } while (0)
#define PG8_WAIT_V(n) asm volatile("s_waitcnt vmcnt(" #n ")" ::: "memory")
#define PG8_WAIT_L(n) asm volatile("s_waitcnt lgkmcnt(" #n ")" ::: "memory")
#define PG8_BAR __builtin_amdgcn_s_barrier()
#define PG8_SCHED __builtin_amdgcn_sched_barrier(0)
    Unit cur, nxt; int ui = 0;
    if (!S.next(0, cur)) return;
    f32x4 acc[2][2][4][2];
#pragma unroll
    for (int a = 0; a < 2; ++a)
#pragma unroll
        for (int b = 0; b < 2; ++b)
#pragma unroll
            for (int m = 0; m < 4; ++m)
#pragma unroll
                for (int n = 0; n < 2; ++n) acc[a][b][m][n] = (f32x4){0.f, 0.f, 0.f, 0.f};
    bf16x8 At[4][2], B0[2][2], B1[2][2];
    const char* cA = (const char*)g.A + (size_t)cur.pm * tstepA; const char* cB = (const char*)g.Bt + (size_t)cur.pn * tstepB;
    PG8_STAGE(PG8_SB(0, 0), cB, voffB); PG8_STAGE(PG8_SA(0, 0), cA, voffA); PG8_STAGE(PG8_SB(0, 1), cB + hstepB, voffB); PG8_STAGE(PG8_SA(0, 1), cA + hstepA, voffA);
    if (wr == 1) PG8_BAR;
    PG8_WAIT_V(4); PG8_BAR;
    PG8_STAGE(PG8_SB(1, 0), cB + kstep, voffB); PG8_STAGE(PG8_SA(1, 0), cA + kstep, voffA); PG8_STAGE(PG8_SB(1, 1), cB + hstepB + kstep, voffB);
    PG8_WAIT_V(6); PG8_BAR;
    for (;;) {
        const bool has_next = S.next(ui + 1, nxt);
        const char* nA = has_next ? (const char*)g.A + (size_t)nxt.pm * tstepA : cA; const char* nB = has_next ? (const char*)g.Bt + (size_t)nxt.pn * tstepB : cB;
        for (int t = 0; t < nt; t += 2) {
            const bool last = (t == nt - 2);
            const char* a1 = cA + (size_t)(t + 1) * kstep;
            const char* a2 = last ? nA : cA + (size_t)(t + 2) * kstep; const char* b2 = last ? nB : cB + (size_t)(t + 2) * kstep;
            const char* a3 = a2 + kstep; const char* b3 = b2 + kstep;
            PG8_LDB(B0, 0, 0); PG8_SCHED; PG8_LDA(At, 0, 0); PG8_STAGE(PG8_SA(1, 1), a1 + hstepA, voffA);
            PG8_WAIT_L(8); PG8_BAR; PG8_WAIT_L(0); PG8_MMA(0, 0, At, B0); PG8_BAR; PG8_SCHED;
            PG8_LDB(B1, 0, 1); PG8_STAGE(PG8_SB(0, 0), b2, voffB);
            PG8_BAR; PG8_WAIT_L(0); PG8_MMA(0, 1, At, B1); PG8_BAR;
            PG8_LDA(At, 0, 1); PG8_STAGE(PG8_SA(0, 0), a2, voffA);
            PG8_BAR; PG8_WAIT_L(0); PG8_MMA(1, 0, At, B0); PG8_BAR; PG8_SCHED;
            PG8_STAGE(PG8_SB(0, 1), b2 + hstepB, voffB);
            PG8_WAIT_V(6); PG8_BAR; PG8_MMA(1, 1, At, B1); PG8_BAR;
            PG8_LDB(B0, 1, 0); PG8_SCHED; PG8_LDA(At, 1, 0); PG8_STAGE(PG8_SA(0, 1), a2 + hstepA, voffA);
            PG8_WAIT_L(8); PG8_BAR; PG8_WAIT_L(0); PG8_MMA(0, 0, At, B0); PG8_BAR; PG8_SCHED;
            PG8_LDB(B1, 1, 1); PG8_STAGE(PG8_SB(1, 0), b3, voffB);
            PG8_BAR; PG8_WAIT_L(0); PG8_MMA(0, 1, At, B1); PG8_BAR;
            PG8_LDA(At, 1, 1); PG8_STAGE(PG8_SA(1, 0), a3, voffA);
            PG8_BAR; PG8_WAIT_L(0); PG8_MMA(1, 0, At, B0); PG8_BAR; PG8_SCHED;
            PG8_STAGE(PG8_SB(1, 1), b3 + hstepB, voffB);
            PG8_WAIT_V(6); PG8_BAR; PG8_MMA(1, 1, At, B1); PG8_BAR;
        }
        E(acc, cur, wr, wc, fr, fq);
        if (!has_next) break;
#pragma unroll
        for (int a = 0; a < 2; ++a)
#pragma unroll
            for (int b = 0; b < 2; ++b)
#pragma unroll
                for (int m = 0; m < 4; ++m)
#pragma unroll
                    for (int n = 0; n < 2; ++n) acc[a][b][m][n] = (f32x4){0.f, 0.f, 0.f, 0.f};
        cur = nxt; cA = nA; cB = nB; ++ui;
    }
    PG8_WAIT_V(0);
    if (wr == 0) PG8_BAR;
    PG8_BAR;
#undef PG8_SA
#undef PG8_SB
#undef PG8_STAGE
#undef PG8_LDA
#undef PG8_LDB
#undef PG8_MMA
#undef PG8_WAIT_V
#undef PG8_WAIT_L
#undef PG8_BAR
#undef PG8_SCHED
}
}
using pg8::Unit;

#define EPI_LOOP_ROWS for (int ai = 0; ai < 2; ++ai) for (int m = 0; m < 4; ++m)

struct EpiStoreBf16 {
    bf16_t* O; int ldc;
    __device__ __forceinline__ void operator()(const f32x4 (&acc)[2][2][4][2], const Unit& u, int wr, int wc, int fr, int fq) const {
        const int row0 = u.pm * 256 + wr * 64 + fr, col0 = u.pn * 256 + wc * 32 + 4 * fq;
#pragma unroll
        EPI_LOOP_ROWS { bf16_t* rowp = O + (size_t)(row0 + ai * 128 + m * 16) * ldc + col0;
#pragma unroll
            for (int bj = 0; bj < 2; ++bj)
#pragma unroll
                for (int n = 0; n < 2; ++n) { const f32x4 v = acc[ai][bj][m][n]; st4(rowp + bj * 128 + n * 16, v[0], v[1], v[2], v[3]); } }
    }
};
struct EpiStoreF32 {
    float* C; int ldc;
    __device__ __forceinline__ void operator()(const f32x4 (&acc)[2][2][4][2], const Unit& u, int wr, int wc, int fr, int fq) const {
        const int row0 = u.pm * 256 + wr * 64 + fr, col0 = wc * 32 + 4 * fq;
#pragma unroll
        EPI_LOOP_ROWS { float* rowp = C + (size_t)(row0 + ai * 128 + m * 16) * ldc + col0;
#pragma unroll
            for (int bj = 0; bj < 2; ++bj)
#pragma unroll
                for (int n = 0; n < 2; ++n) *(f32x4*)(rowp + bj * 128 + n * 16) = acc[ai][bj][m][n]; }
    }
};
struct EpiLoraWA {
    bf16_t *nldf, *nldb, *af, *ab; const float* w0; const float* a0;
    __device__ __forceinline__ void operator()(const f32x4 (&acc)[2][2][4][2], const Unit& u, int wr, int wc, int fr, int fq) const {
        const int h = u.pn, ch = 16 * wc + 4 * fq, c = 64 * h + ch;
        const int b = u.pm / 17, tp0 = (u.pm - b * 17) * 256 + wr * 64 + fr;
        const size_t idx0 = ((size_t)(b * 16 + h) * TP + tp0) * 64 + ch;
#pragma unroll
        for (int arr = 0; arr < 4; ++arr) {
            const int bj = arr & 1, n = arr >> 1;
            const f32x4 bias = *(const f32x4*)((n ? a0 : w0) + bj * 1024 + c);
            bf16_t* dst = (arr == 0 ? nldf : arr == 1 ? nldb : arr == 2 ? af : ab) + idx0;
            const float sc = n ? 1.f : 0.60653066f;
#pragma unroll
            for (int ai = 0; ai < 2; ++ai)
#pragma unroll
                for (int m = 0; m < 4; ++m) { const f32x4 v = acc[ai][bj][m][n];
                    st4(dst + (size_t)(ai * 128 + m * 16) * 64, sc * sigmoid_(bias[0] + v[0]), sc * sigmoid_(bias[1] + v[1]), sc * sigmoid_(bias[2] + v[2]), sc * sigmoid_(bias[3] + v[3])); }
            asm volatile("" ::: "memory");
        }
    }
};
struct EpiS5Y {
    bf16_t* Z;
    __device__ __forceinline__ void operator()(const f32x4 (&acc)[2][2][4][2], const Unit& u, int wr, int wc, int fr, int fq) const {
        const int g = u.pm / 5, lp = u.pm - g * 5;
#pragma unroll
        EPI_LOOP_ROWS {
            const int lr = lp * 256 + ai * 128 + wr * 64 + m * 16 + fr;
            { const int b = lr >> 8, sl = lr & 255;
#pragma unroll
                    for (int bj = 0; bj < 2; ++bj)
#pragma unroll
                        for (int n = 0; n < 2; ++n) { const int tau = 8 * bj + 2 * wc + n; const int t = sl * 16 + tau; const f32x4 v = acc[ai][bj][m][n];
                            st4(Z + (size_t)(b * T + t) * 1024 + g * 16 + 4 * fq, gelu_(v[0]), gelu_(v[1]), gelu_(v[2]), gelu_(v[3])); } }
        }
    }
};
struct EpiGLU {
    const bf16_t* Z; bf16_t* O; const float* bias;
    __device__ __forceinline__ void operator()(const f32x4 (&acc)[2][2][4][2], const Unit& u, int wr, int wc, int fr, int fq) const {
        const int row0 = u.pm * 256 + wr * 64 + fr, col0 = u.pn * 256 + wc * 32 + 4 * fq;
#pragma unroll
        EPI_LOOP_ROWS { const size_t row = row0 + ai * 128 + m * 16;
#pragma unroll
            for (int bj = 0; bj < 2; ++bj)
#pragma unroll
                for (int n = 0; n < 2; ++n) { const int col = col0 + bj * 128 + n * 16; const f32x4 v = acc[ai][bj][m][n]; const f32x4 bv = *(const f32x4*)(bias + col);
                    const uint2 zz = *(const uint2*)(Z + row * 1024 + col);
                    st4(O + row * 2048 + 1024 + col, bflo(zz.x) * sigmoid_(v[0] + bv[0]), bfhi(zz.x) * sigmoid_(v[1] + bv[1]), bflo(zz.y) * sigmoid_(v[2] + bv[2]), bfhi(zz.y) * sigmoid_(v[3] + bv[3])); } }
    }
};
struct EpiResid {
    const float* base; float* out; const float* gate;
    __device__ __forceinline__ void operator()(const f32x4 (&acc)[2][2][4][2], const Unit& u, int wr, int wc, int fr, int fq) const {
        const int row0 = u.pm * 256 + wr * 64 + fr, col0 = u.pn * 256 + wc * 32 + 4 * fq;
        const float* gp = gate + (size_t)((u.pm * 256) / T) * 12288;
        f32x4 gvv[2][2];
#pragma unroll
        for (int bj = 0; bj < 2; ++bj)
#pragma unroll
            for (int n = 0; n < 2; ++n) gvv[bj][n] = *(const f32x4*)(gp + col0 + bj * 128 + n * 16);
#pragma unroll
        EPI_LOOP_ROWS { const size_t row = row0 + ai * 128 + m * 16;
#pragma unroll
            for (int bj = 0; bj < 2; ++bj)
#pragma unroll
                for (int n = 0; n < 2; ++n) { const int col = col0 + bj * 128 + n * 16; const f32x4 xv = *(const f32x4*)(base + row * 2048 + col);
                    *(f32x4*)(out + row * 2048 + col) = xv + gvv[bj][n] * acc[ai][bj][m][n]; } }
    }
};
struct EpiFFNUp {
    bf16_t* H; const float* cw; const float* cb;
    __device__ __forceinline__ void operator()(const f32x4 (&acc)[2][2][4][2], const Unit& u, int wr, int wc, int fr, int fq) const {
        const int row0 = u.pm * 256 + wr * 64 + fr;
#pragma unroll
        for (int n = 0; n < 2; ++n) {
            const int f0 = u.pn * 128 + wc * 32 + n * 16 + 4 * fq;
            const f32x4 c0 = *(const f32x4*)(cw + f0), c1 = *(const f32x4*)(cw + DFF + f0), c2 = *(const f32x4*)(cw + 2 * DFF + f0), cbv = *(const f32x4*)(cb + f0);
#pragma unroll
            for (int ai = 0; ai < 2; ++ai) {
#pragma unroll
                for (int m = 0; m < 4; ++m) {
                    float o[4];
#pragma unroll
                    for (int j = 0; j < 4; ++j) {
                        const float gc = acc[ai][0][m][n][j];
                        const float rp = dpp_<0x121>(gc), rn = dpp_<0x12F>(gc);
                        const float pm1 = (m > 0) ? dpp_<0x121>(acc[ai][0][m > 0 ? m - 1 : 0][n][j]) : 0.f;
                        const float nm1 = (m < 3) ? dpp_<0x12F>(acc[ai][0][m < 3 ? m + 1 : 3][n][j]) : 0.f;
                        const float pv = (fr == 0) ? pm1 : rp, nv = (fr == 15) ? nm1 : rn;
                        const float gt = c0[j] * pv + c1[j] * gc + c2[j] * nv + cbv[j];
                        o[j] = gelu_(gt) * acc[ai][1][m][n][j];
                    }
                    st4(H + (size_t)(row0 + ai * 128 + m * 16) * DFF + f0, o[0], o[1], o[2], o[3]);
                }
            }
        }
    }
};

__device__ __forceinline__ int srccol(int kind, int n) { return kind == 3 ? (((n >> 7) & 1) * DFF + (n >> 8) * 128 + (n & 127)) : n; }
__device__ void transpose_weight(const float* src, int ldn, int nvalid, int K, int Np, int kind, bf16_t* dst, const int tid, const int woff = 0) {
    const int lane = tid & 63, gw = blockIdx.x * 8 + (tid >> 6), nw = gridDim.x * 8;
    const int ntn = Np / 64, ntile = ntn * (K / 64);
    for (int tl = (gw - woff % nw + nw) % nw; tl < ntile; tl += nw) {
        const int tk = tl / ntn, tn = tl - tk * ntn, n = tn * 64 + lane, k0 = tk * 64;
        const bool ok = n < nvalid; const float* sp = src + (size_t)k0 * ldn + (ok ? srccol(kind, n) : 0);
        float v[64];
#pragma unroll
        for (int i = 0; i < 64; ++i) v[i] = __builtin_nontemporal_load(sp + (size_t)i * ldn);
        bf16_t* dp = dst + (size_t)n * K + k0;
#pragma unroll
        for (int i = 0; i < 8; ++i) { uint4 u; u.x = cvt_pk_bf16(v[8 * i], v[8 * i + 1]); u.y = cvt_pk_bf16(v[8 * i + 2], v[8 * i + 3]); u.z = cvt_pk_bf16(v[8 * i + 4], v[8 * i + 5]); u.w = cvt_pk_bf16(v[8 * i + 6], v[8 * i + 7]);
            if (!ok) u = make_uint4(0u, 0u, 0u, 0u);
            *(uint4*)(dp + 8 * i) = u; }
    }
}
__device__ __forceinline__ void s5_lam(const Params& P, int d, int g, int p, float& lr, float& li, float& fre, float& fim) {
    const float dt = expf(P.in[21][d * 64 + g]); const float are = P.in[19][(d * 64 + g) * 64 + p], aim = P.in[20][(d * 64 + g) * 64 + p];
    const float mag = expf(are * dt); float c, s; cis_(aim * dt, c, s); lr = mag * c; li = mag * s;
    const float den = are * are + aim * aim, nr = lr - 1.f; fre = (nr * are + li * aim) / den; fim = (li * are - nr * aim) / den;
}

__device__ void phase0(const Params& P, float* ldsf, const int tid) {
    const int nblk = gridDim.x, blk = blockIdx.x;
    unsigned char* ws = P.ws;
    transpose_weight(P.in[7], NIN, NIN, 2048, NINP, 0, (bf16_t*)(ws + WS_WT_IN), tid);
    transpose_weight(P.in[27], 1024, 1024, 1024, 1024, 1, (bf16_t*)(ws + WS_WT_GLU), tid, 2304);
    transpose_weight(P.in[29], 2048, 2048, 2048, 2048, 2, (bf16_t*)(ws + WS_WT_OUT), tid, 2304 + 256);
    { bf16_t* wa = (bf16_t*)(ws + WS_WT_WA); const float* wup = P.in[10]; const float* aup = P.in[12];
      for (int id = blk * 512 + tid; id < 4096 * 256; id += nblk * 512) { const int n = id >> 8, k = id & 255; const int h = n >> 8, dir = (n >> 7) & 1, wc = (n >> 5) & 3, type = (n >> 4) & 1, fq = (n >> 2) & 3, j = n & 3;
          const int c = 64 * h + 16 * wc + 4 * fq + j, kb = k >> 6, kk = k & 63; float v = 0.f;
          if (type == 0) { if (kb == dir) v = wup[(dir * 64 + kk) * 1024 + c]; } else { if (kb == 2 + dir) v = aup[(dir * 64 + kk) * 1024 + c]; }
          wa[id] = f2bf(v); }
      bf16_t* wg = (bf16_t*)(ws + WS_WT_G); const float* gup = P.in[13];
      for (int id = blk * 512 + tid; id < 1024 * 256; id += nblk * 512) { const int n = id >> 8, k = id & 255; wg[id] = f2bf(k < 160 ? gup[k * 1024 + n] : 0.f); } }
    { float* mp = (float*)(ws + WS_MODPART2); const float* mw = P.in[4];
      for (int ch = blk; ch < 192; ch += nblk) { const int ks = ch / 6, col = ((ch - ks * 6) * 512 + tid) * 4;
          __syncthreads();
          if (tid < 320) { const int r = tid >> 6, kk = tid & 63; const float cv = (r < 4) ? P.in[1][r * 2048 + ks * 64 + kk] : P.in[3][ks * 64 + kk]; ldsf[tid] = cv * sigmoid_(cv); }
          __syncthreads();
          f32x4 a0 = {0.f, 0.f, 0.f, 0.f}, a1 = a0, a2 = a0, a3 = a0, a4 = a0; const float* wp = mw + (size_t)(ks * 64) * 12288 + col;
#pragma unroll 16
          for (int kk = 0; kk < 64; ++kk) { const f32x4 w = ldnt4(wp + (size_t)kk * 12288); a0 += ldsf[kk] * w; a1 += ldsf[64 + kk] * w; a2 += ldsf[128 + kk] * w; a3 += ldsf[192 + kk] * w; a4 += ldsf[256 + kk] * w; }
          float* o = mp + (size_t)ks * 5 * 12288 + col; *(f32x4*)(o) = a0; *(f32x4*)(o + 12288) = a1; *(f32x4*)(o + 2 * 12288) = a2; *(f32x4*)(o + 3 * 12288) = a3; *(f32x4*)(o + 4 * 12288) = a4; }
      __syncthreads(); }
    { float* kt = (float*)(ws + WS_KTAB4);
      for (int id4 = blk * 512 + tid; id4 < 131072; id4 += nblk * 512) { const int pq = id4 >> 15, id = id4 & 32767; const int g = id >> 9, d = (id >> 8) & 1, h = (id >> 4) & 15, hp = id & 15;
          float acc[16];
#pragma unroll
          for (int l = 0; l < 16; ++l) acc[l] = 0.f;
          float lrm, lim, frm, fim_m; s5_lam(P, d, g, pq * 16 + hp, lrm, lim, frm, fim_m);
          for (int pj = 0; pj < 16; ++pj) { const int p = pq * 16 + pj; const float lr = __shfl(lrm, pj, 16), li = __shfl(lim, pj, 16), fre = __shfl(frm, pj, 16), fim = __shfl(fim_m, pj, 16);
              const float br = P.in[22][((d * 64 + g) * 64 + p) * 16 + hp], bi = P.in[23][((d * 64 + g) * 64 + p) * 16 + hp];
              const float bbr = fre * br - fim * bi, bbi = fre * bi + fim * br;
              const float cr = P.in[24][((d * 64 + g) * 16 + h) * 64 + p], ci = P.in[25][((d * 64 + g) * 16 + h) * 64 + p];
              const float xr = cr * bbr - ci * bbi, xi = cr * bbi + ci * bbr; float er = 1.f, ei = 0.f;
#pragma unroll
              for (int l = 0; l < 16; ++l) { acc[l] += xr * er - xi * ei; const float nr = er * lr - ei * li; ei = er * li + ei * lr; er = nr; } }
#pragma unroll
          for (int l = 0; l < 16; ++l) kt[(size_t)pq * 524288 + ((g * 2 + d) * 16 + l) * 256 + h * 16 + hp] = acc[l]; } }
    { bf16_t* bt = (bf16_t*)(ws + WS_BT_S5);
      for (int id = blk * 512 + tid; id < 131072; id += nblk * 512) { const int g = id >> 11, d = (id >> 10) & 1, p = (id >> 4) & 63, hp = id & 15;
          float lr, li, fre, fim; s5_lam(P, d, g, p, lr, li, fre, fim);
          const float br = P.in[22][((d * 64 + g) * 64 + p) * 16 + hp], bi = P.in[23][((d * 64 + g) * 64 + p) * 16 + hp];
          float vr = fre * br - fim * bi, vi = fre * bi + fim * br;
          bf16_t* rowr = bt + ((size_t)g * 256 + d * 128 + p) * 256; bf16_t* rowi = rowr + 64 * 256;
          for (int e = 0; e < 16; ++e) { const int tau = d ? e : 15 - e; rowr[tau * 16 + hp] = f2bf(vr); rowi[tau * 16 + hp] = f2bf(vi);
              const float nr = vr * lr - vi * li; vi = vr * li + vi * lr; vr = nr; } } }
    { bf16_t* tc = (bf16_t*)(ws + WS_TC_S5);
      for (int id = blk * 512 + tid; id < 131072; id += nblk * 512) { const int g = id >> 11, d = (id >> 10) & 1, h = (id >> 6) & 15, p = id & 63;
          float lr, li, fre, fim; s5_lam(P, d, g, p, lr, li, fre, fim);
          const float cr = P.in[24][((d * 64 + g) * 16 + h) * 64 + p], ci = P.in[25][((d * 64 + g) * 16 + h) * 64 + p];
          float gr = cr * lr - ci * li, gi = cr * li + ci * lr;
          for (int e = 1; e <= 16; ++e) { const int t = d ? 16 - e : e - 1; bf16_t* row = tc + ((size_t)g * 256 + t * 16 + h) * 512 + 256 + d * 128 + p;
              row[0] = f2bf(gr); row[64] = f2bf(-gi);
              const float nr = gr * lr - gi * li; gi = gr * li + gi * lr; gr = nr; } } }
}

__device__ void phase0b(const Params& P, const int tid) {
    const int nblk = gridDim.x, blk = blockIdx.x; unsigned char* ws = P.ws;
    { const float* mp = (const float*)(ws + WS_MODPART2); float* mv = (float*)(ws + WS_MODV);
      for (int id = blk * 512 + tid; id < 5 * 12288; id += nblk * 512) { const int col = id % 12288; float a = P.in[5][col];
#pragma unroll 8
          for (int ks = 0; ks < 32; ++ks) a += mp[(size_t)ks * 5 * 12288 + id];
          mv[id] = a; } }
    { const float* kt = (const float*)(ws + WS_KTAB4); bf16_t* tc = (bf16_t*)(ws + WS_TC_S5); const float* dd = P.in[26];
      for (int id = blk * 512 + tid; id < 64 * 65536; id += nblk * 512) { const int g = id >> 16, n = (id >> 8) & 255, k = id & 255; const int t = n >> 4, h = n & 15, tau = k >> 4, hp = k & 15;
          float v = 0.f;
          if (tau <= t) { const float* q = kt + ((g * 2 + 0) * 16 + (t - tau)) * 256 + h * 16 + hp; v += (q[0] + q[524288]) + (q[2 * 524288] + q[3 * 524288]); }
          if (tau >= t) { const float* q = kt + ((g * 2 + 1) * 16 + (tau - t)) * 256 + h * 16 + hp; v += (q[0] + q[524288]) + (q[2 * 524288] + q[3 * 524288]); }
          if (k == n) v += dd[g * 16 + h];
          tc[((size_t)g * 256 + n) * 512 + k] = f2bf(v); } }
}

__device__ void phase_norm_mod(const Params& P, int which, const int tid) {
    const int lane = tid & 63, gw = blockIdx.x * 8 + (tid >> 6), nw = gridDim.x * 8;
    const float* mv = (const float*)(P.ws + WS_MODV);
    const float* gam = P.in[which == 0 ? 6 : 30];
    bf16_t* dst = (bf16_t*)(P.ws + (which == 0 ? WS_HX : WS_HX2));
    f32x4 gv[8];
#pragma unroll
    for (int i = 0; i < 8; ++i) gv[i] = *(const f32x4*)(gam + lane * 4 + 256 * i);
    if (which == 0) {
#pragma unroll 2
        for (int row = gw; row < MT; row += nw) {
            const float* src; int mrow;
            { const int b = row / TP, tp = row - b * TP; if (tp < TCX) { src = P.in[2] + (size_t)(b * TCX + tp) * D; mrow = 4; } else { src = P.in[0] + (size_t)(b * T + tp - TCX) * D; mrow = b; } }
            const float* sh = mv + (size_t)mrow * 12288; const float* sc = sh + 2048;
            f32x4 v[8]; float ss = 0.f;
#pragma unroll
            for (int i = 0; i < 8; ++i) { v[i] = ldnt4(src + lane * 4 + 256 * i); ss += v[i][0] * v[i][0] + v[i][1] * v[i][1] + v[i][2] * v[i][2] + v[i][3] * v[i][3]; }
            ss = wave_sum(ss); const float rstd = rsqrtf(ss * (1.f / 2048.f) + 1e-6f);
#pragma unroll
            for (int i = 0; i < 8; ++i) { const int c = lane * 4 + 256 * i; const f32x4 scv = *(const f32x4*)(sc + c), shv = *(const f32x4*)(sh + c);
                float o[4];
#pragma unroll
                for (int j = 0; j < 4; ++j) o[j] = (v[i][j] * rstd * gv[i][j]) * (1.f + scv[j]) + shv[j];
                st4(dst + (size_t)row * D + c, o[0], o[1], o[2], o[3]); }
        }
    } else {
        for (int grp = gw; grp < ML / 8; grp += nw) {
            const int row0 = grp * 8, mrow = row0 / T;
            const float* sh = mv + (size_t)mrow * 12288 + 3 * 2048; const float* sc = sh + 2048;
            f32x4 gs[8], shv[8];
#pragma unroll
            for (int i = 0; i < 8; ++i) { const int c = lane * 4 + 256 * i; const f32x4 scv = *(const f32x4*)(sc + c); shv[i] = *(const f32x4*)(sh + c); gs[i] = gv[i] * (1.f + scv); }
#pragma unroll 2
            for (int r = 0; r < 8; ++r) { const int row = row0 + r; const float* src = P.out + (size_t)row * D;
                f32x4 v[8]; float ss = 0.f;
#pragma unroll
                for (int i = 0; i < 8; ++i) { v[i] = ldnt4(src + lane * 4 + 256 * i); ss += v[i][0] * v[i][0] + v[i][1] * v[i][1] + v[i][2] * v[i][2] + v[i][3] * v[i][3]; }
                ss = wave_sum(ss); const float rstd = rsqrtf(ss * (1.f / 2048.f) + 1e-6f);
#pragma unroll
                for (int i = 0; i < 8; ++i) { const int c = lane * 4 + 256 * i; const f32x4 o = v[i] * rstd * gs[i] + shv[i];
                    st4(dst + (size_t)row * D + c, o[0], o[1], o[2], o[3]); }
            }
        }
    }
}
__device__ void phase_final_norm(const Params& P, const int tid) {
    const int lane = tid & 63, gw = blockIdx.x * 8 + (tid >> 6), nw = gridDim.x * 8; const float* gam = P.in[35];
    f32x4 gv[8];
#pragma unroll
    for (int i = 0; i < 8; ++i) gv[i] = *(const f32x4*)(gam + lane * 4 + 256 * i);
#pragma unroll 2
    for (int row = gw; row < ML; row += nw) { float* src = P.out + (size_t)row * D; f32x4 v[8]; float ss = 0.f;
#pragma unroll
        for (int i = 0; i < 8; ++i) { v[i] = ldnt4(src + lane * 4 + 256 * i); ss += v[i][0] * v[i][0] + v[i][1] * v[i][1] + v[i][2] * v[i][2] + v[i][3] * v[i][3]; }
        ss = wave_sum(ss); const float rstd = rsqrtf(ss * (1.f / 2048.f) + 1e-6f);
#pragma unroll
        for (int i = 0; i < 8; ++i) { const int c = lane * 4 + 256 * i; stnt4(src + c, v[i] * rstd * gv[i]); } }
}

__device__ __forceinline__ int s5row(int b, int sc) { return sc >= 16 ? b * 256 + (sc - 16) : 1024 + b * 16 + sc; }
__device__ __forceinline__ void unpack8(const uint4 u, float (&o)[8]) { o[0] = bflo(u.x); o[1] = bfhi(u.x); o[2] = bflo(u.y); o[3] = bfhi(u.y); o[4] = bflo(u.z); o[5] = bfhi(u.z); o[6] = bflo(u.w); o[7] = bfhi(u.w); }
__device__ __forceinline__ void shift8(const uint4 pv, const uint4 cu, const uint4 nx, const float (&m0)[8], const float (&m1)[8], float (&q)[8]) {
    float a[8], b[8], c[8]; unpack8(pv, a); unpack8(cu, b); unpack8(nx, c);
#pragma unroll
    for (int e = 0; e < 8; ++e) q[e] = b[e] + m0[e] * (a[e] - b[e]) + m1[e] * (c[e] - b[e]);
}
__device__ __forceinline__ void ldc8(const float* p, float (&o)[8]) { const f32x4 a = *(const f32x4*)p, b = *(const f32x4*)(p + 4); o[0] = a[0]; o[1] = a[1]; o[2] = a[2]; o[3] = a[3]; o[4] = b[0]; o[5] = b[1]; o[6] = b[2]; o[7] = b[3]; }

__device__ void phase_prep(const Params& P, const int tid) {
    const int lane = tid & 63, gw = blockIdx.x * 8 + (tid >> 6), nw = gridDim.x * 8;
    const bf16_t* Pb = (const bf16_t*)(P.ws + WS_P); unsigned char* dob = (unsigned char*)P.out;
    bf16_t* Rr = (bf16_t*)(dob + DO_R); bf16_t* Kr = (bf16_t*)(dob + DO_K); bf16_t* KKr = (bf16_t*)(dob + DO_KK); bf16_t* As = (bf16_t*)(dob + DO_ASMALL);
    bf16_t* Vr = (bf16_t*)(P.ws + WS_V); bf16_t* A2 = (bf16_t*)(P.ws + WS_A2); float* bonus = (float*)(P.ws + WS_BONUS);
    const float* mu = P.in[8]; const float* k_k = P.in[14]; const float* r_k = P.in[16];
    const uint4 z4 = make_uint4(0u, 0u, 0u, 0u);
    constexpr int NFULL = 6144, NITEM = NFULL + 2 * ((MT / 8) * 3 - NFULL);
    for (int item = gw; item < NITEM; item += nw) {
        int run, sect, j0 = 0, nj = 8;
        if (item < NFULL) { run = item / 3; sect = item - run * 3; } else { const int hx_ = item - NFULL, it_ = NFULL + (hx_ >> 1); run = it_ / 3; sect = it_ - run * 3; j0 = (hx_ & 1) * 4; nj = 4; }
        const int R0 = run * 8 + j0;
        const int b = R0 / TP, tp0 = R0 - b * TP;
        const int ti0 = tp0 < TCX ? tp0 : ((tp0 - TCX) & 63), rowlen = tp0 < TCX ? TCX : 64;
        const bf16_t* pr0 = Pb + (size_t)R0 * NINP;
        if (sect < 2) {
            const int col = sect * 512 + lane * 8, head = sect * 8 + (lane >> 3), ch0 = (lane & 7) * 8;
            float mr0[8], mr1[8], mk0[8], mk1[8], mv0[8], mv1[8], kkc[8], rkc[8];
            ldc8(mu + col, mr0); ldc8(mu + RIN + col, mr1); ldc8(mu + 1024 + col, mk0); ldc8(mu + RIN + 1024 + col, mk1); ldc8(mu + 2048 + col, mv0); ldc8(mu + RIN + 2048 + col, mv1);
            ldc8(k_k + col, kkc); ldc8(r_k + col, rkc);
            uint4 pr_ = z4, pk_ = z4, pv_ = z4, cr_, ck_, cv_;
            if (ti0 > 0) { pr_ = ldnt16(pr0 - NINP + col); pk_ = ldnt16(pr0 - NINP + 1024 + col); pv_ = ldnt16(pr0 - NINP + 2048 + col); }
            cr_ = ldnt16(pr0 + col); ck_ = ldnt16(pr0 + 1024 + col); cv_ = ldnt16(pr0 + 2048 + col);
#pragma unroll 2
            for (int j = 0; j < nj; ++j) {
                const bf16_t* prn = pr0 + (size_t)(j + 1) * NINP; uint4 nr_ = z4, nk_ = z4, nv_ = z4;
                if (ti0 + j + 1 < rowlen) { nr_ = ldnt16(prn + col); nk_ = ldnt16(prn + 1024 + col); nv_ = ldnt16(prn + 2048 + col); }
                float r8[8], k8[8], v8[8], kk8[8]; shift8(pr_, cr_, nr_, mr0, mr1, r8); shift8(pk_, ck_, nk_, mk0, mk1, k8); shift8(pv_, cv_, nv_, mv0, mv1, v8);
                float ss = 0.f, bon = 0.f;
#pragma unroll
                for (int e = 0; e < 8; ++e) { kk8[e] = k8[e] * kkc[e]; ss += kk8[e] * kk8[e]; bon += r8[e] * k8[e] * rkc[e]; }
                ss += __shfl_xor(ss, 1, 64); ss += __shfl_xor(ss, 2, 64); ss += __shfl_xor(ss, 4, 64);
                bon += __shfl_xor(bon, 1, 64); bon += __shfl_xor(bon, 2, 64); bon += __shfl_xor(bon, 4, 64);
                const float inv = 1.f / fmaxf(sqrtf(ss), 1e-12f);
#pragma unroll
                for (int e = 0; e < 8; ++e) kk8[e] *= inv;
                const size_t idx = ((size_t)(b * 16 + head) * TP + tp0 + j) * 64 + ch0;
                st8(Rr + idx, r8); st8(Kr + idx, k8); st8(Vr + idx, v8); st8(KKr + idx, kk8);
                if ((lane & 7) == 0) bonus[(size_t)(R0 + j) * 16 + head] = bon;
                pr_ = cr_; pk_ = ck_; pv_ = cv_; cr_ = nr_; ck_ = nk_; cv_ = nv_;
            }
        } else {
            const int c0 = 3072 + (lane < 52 ? lane : 0) * 8;
            float m0[8], m1[8]; ldc8(mu + c0, m0); ldc8(mu + RIN + c0, m1);
            int dc, act;
            if (lane >= 52) { dc = 416 + (lane - 52) * 8; act = 3; } else if (c0 < 3232) { dc = 256 + (c0 - 3072); act = 0; } else if (c0 < 3360) { dc = c0 - 3232; act = 1; } else { dc = 128 + (c0 - 3360); act = 2; }
            uint4 pq_ = z4, cq_;
            if (ti0 > 0) pq_ = ldnt16(pr0 - NINP + c0);
            cq_ = ldnt16(pr0 + c0);
#pragma unroll 2
            for (int j = 0; j < nj; ++j) {
                const bf16_t* prc = pr0 + (size_t)j * NINP; uint4 nq_ = z4;
                if (ti0 + j + 1 < rowlen) nq_ = ldnt16(prc + NINP + c0);
                const uint4 u0 = ldnt16(prc + RIN + lane * 8), u1 = *(const uint4*)(prc + RIN + 512 + lane * 8);
                float q[8]; shift8(pq_, cq_, nq_, m0, m1, q);
#pragma unroll
                for (int e = 0; e < 8; ++e) q[e] = act == 0 ? sigmoid_(q[e]) : act == 1 ? tanh_(q[e]) : act == 2 ? q[e] : 0.f;
                st8(As + (size_t)(R0 + j) * 512 + dc, q);
                const int tp = tp0 + j;
                { const int c = lane * 8, gidx = c >> 4, hp0 = c & 15; *(uint4*)(A2 + ((size_t)gidx * 1280 + s5row(b, tp >> 4)) * 512 + (tp & 15) * 16 + hp0) = u0; }
                { const int c = lane * 8 + 512, gidx = c >> 4, hp0 = c & 15; *(uint4*)(A2 + ((size_t)gidx * 1280 + s5row(b, tp >> 4)) * 512 + (tp & 15) * 16 + hp0) = u1; }
                pq_ = cq_; cq_ = nq_;
            }
        }
    }
}

__device__ void phase_post(const Params& P, const int tid) {
    const int lane = tid & 63, gw = blockIdx.x * 8 + (tid >> 6), nw = gridDim.x * 8;
    const bf16_t* YF = (const bf16_t*)(P.ws + WS_YF); const bf16_t* YB = (const bf16_t*)(P.ws + WS_YB); const bf16_t* Vr = (const bf16_t*)(P.ws + WS_V);
    const bf16_t* G = (const bf16_t*)(P.ws + WS_G); const float* bonus = (const float*)(P.ws + WS_BONUS); bf16_t* O = (bf16_t*)(P.ws + WS_O);
    const float* lw = P.in[17]; const float* lb = P.in[18];
#pragma unroll 2
    for (int Rl = gw; Rl < ML; Rl += nw) { const int b = Rl / T, t = Rl - b * T; const size_t R = (size_t)b * TP + TCX + t;
#pragma unroll 1
        for (int half = 0; half < 2; ++half) { const int head = half * 8 + (lane >> 3), ch0 = (lane & 7) * 8, c = head * 64 + ch0;
            float yf[8], yb[8], v8[8], g8[8]; ld8nt(YF + (size_t)Rl * 1024 + c, yf); ld8nt(YB + (size_t)Rl * 1024 + c, yb);
            ld8(Vr + ((size_t)(b * 16 + head) * TP + TCX + t) * 64 + ch0, v8); ld8nt(G + R * 1024 + c, g8);
            float s = 0.f;
#pragma unroll
            for (int e = 0; e < 8; ++e) { yf[e] += yb[e]; s += yf[e]; }
            s += __shfl_xor(s, 1, 64); s += __shfl_xor(s, 2, 64); s += __shfl_xor(s, 4, 64); const float mean = s * (1.f / 64.f);
            float vs = 0.f;
#pragma unroll
            for (int e = 0; e < 8; ++e) { yf[e] -= mean; vs += yf[e] * yf[e]; }
            vs += __shfl_xor(vs, 1, 64); vs += __shfl_xor(vs, 2, 64); vs += __shfl_xor(vs, 4, 64); const float rstd = rsqrtf(vs * (1.f / 64.f) + 64e-5f);
            const float bon = bonus[R * 16 + head]; float o[8];
#pragma unroll
            for (int e = 0; e < 8; ++e) o[e] = (yf[e] * rstd * lw[c + e] + lb[c + e] + bon * v8[e]) * g8[e];
            st8(O + (size_t)Rl * 2048 + c, o); }
    }
}

__device__ void phase_s5_scan(const Params& P, const int tid) {
    if (tid >= 128) return;
    const float* W = (const float*)(P.ws + WS_W); bf16_t* A2 = (bf16_t*)(P.ws + WS_A2);
    for (int gid = blockIdx.x * 128 + tid; gid < 32768; gid += gridDim.x * 128) {
        const int p = gid & 63, d = (gid >> 6) & 1, g = (gid >> 7) & 63, b = gid >> 13;
        const float dt = expf(P.in[21][d * 64 + g]); const float are = P.in[19][(d * 64 + g) * 64 + p], aim = P.in[20][(d * 64 + g) * 64 + p];
        const float m16 = expf(16.f * are * dt); float c, s; cis_(16.f * aim * dt, c, s); const float lr = m16 * c, li = m16 * s;
        float sr = 0.f, si = 0.f;
        const size_t rowbase = (size_t)g * 1280;
        for (int n0 = 0; n0 < 272; n0 += 34) { float wr_[34], wi_[34]; int sidx[34];
#pragma unroll
            for (int u = 0; u < 34; ++u) { const int n = n0 + u; const int sc = d ? (n < 16 ? 15 - n : 287 - n) : n; sidx[u] = s5row(b, sc);
                const float* wp = W + (rowbase + sidx[u]) * 256 + d * 128 + p; wr_[u] = wp[0]; wi_[u] = wp[64]; }
#pragma unroll
            for (int u = 0; u < 34; ++u) { bf16_t* sp = A2 + (rowbase + sidx[u]) * 512 + 256 + d * 128 + p; sp[0] = f2bf(sr); sp[64] = f2bf(si);
                const float nr = lr * sr - li * si + wr_[u]; si = lr * si + li * sr + wi_[u]; sr = nr; } }
    }
}

typedef unsigned u32x4 __attribute__((ext_vector_type(4)));
__device__ void phase_rwkv_scan(const Params& P, unsigned char* lds, const int tid) {
    constexpr int BLK = 272, SLOT = 12800, O_W1 = 0, O_RR = 2176, O_BK = 4352, O_MAK = 8448, O_PP = 9472, O_GAM = 10496, O_VT = 10752, O_TI = 11776, NSLOT = 7, O_SCR = NSLOT * SLOT, SCRW = 6400, O_FLAG = O_SCR + 6 * SCRW;
    const int wave = __builtin_amdgcn_readfirstlane(tid >> 6), lane = tid & 63;
    unsigned char* dob = (unsigned char*)P.out;
    const bf16_t* Rr = (const bf16_t*)(dob + DO_R); const bf16_t* Kr = (const bf16_t*)(dob + DO_K); const bf16_t* KKr = (const bf16_t*)(dob + DO_KK); const bf16_t* Vr = (const bf16_t*)(P.ws + WS_V);
    int* flag = (int*)(lds + O_FLAG); int* done = flag + 8;
    for (int jb = blockIdx.x; jb < 256; jb += gridDim.x) {
        const int job = ((jb >> 4) << 4) | ((jb & 7) << 1) | ((jb >> 3) & 1);
        const int half = job & 1, d = (job >> 1) & 1, bh = job >> 2, b = bh >> 4, h = bh & 15;
        const bf16_t* NL = (const bf16_t*)(P.ws + (d ? WS_NLDB : WS_NLDF)); const bf16_t* AA = (const bf16_t*)(P.ws + (d ? WS_AB : WS_AF));
        bf16_t* Y = (bf16_t*)(P.ws + (d ? WS_YB : WS_YF));
        const size_t base = (size_t)bh * TP * 64;
#define T0(c) (d == 0 ? 16 * (c) : ((c) < 16 ? 240 - 16 * (c) : 4592 - 16 * (c)))
        __syncthreads();
        if (tid < NSLOT) flag[tid] = -1;
        if (tid < 2) done[tid] = 0;
        __syncthreads();
        if (wave < 2) {
            const int cw = wave, i16 = lane & 15, q = lane >> 4;
            f32x4 S0 = {0.f, 0.f, 0.f, 0.f}, S1 = S0, S2 = S0, S3 = S0;
            const f32x4 zero4 = {0.f, 0.f, 0.f, 0.f};
            for (int c = 0; c < 272; ++c) {
                const int slot = c % NSLOT; const unsigned char* sb = lds + slot * SLOT;
                while (__builtin_amdgcn_readfirstlane(__hip_atomic_load(flag + slot, __ATOMIC_ACQUIRE, __HIP_MEMORY_SCOPE_WORKGROUP)) != c) __builtin_amdgcn_s_sleep(1);
                const int fo = (q * 16 + i16) * 16;
                const int fp = q * BLK + i16 * 16;
                const bf16x8 w10 = *(const bf16x8*)(sb + O_W1 + fp), w11 = *(const bf16x8*)(sb + O_W1 + 4 * BLK + fp);
                const bf16x8 rr0 = *(const bf16x8*)(sb + O_RR + fp), rr1 = *(const bf16x8*)(sb + O_RR + 4 * BLK + fp);
                const bf16x8 bk0 = *(const bf16x8*)(sb + O_BK + fo), bk1 = *(const bf16x8*)(sb + O_BK + 1024 + fo), bk2 = *(const bf16x8*)(sb + O_BK + 2048 + fo), bk3 = *(const bf16x8*)(sb + O_BK + 3072 + fo);
                const bf16x8 mak = *(const bf16x8*)(sb + O_MAK + fo), pp = *(const bf16x8*)(sb + O_PP + fo), ti = *(const bf16x8*)(sb + O_TI + fo);
                const f32x4 g0 = *(const f32x4*)(sb + O_GAM + (4 * q) * 4), g1 = *(const f32x4*)(sb + O_GAM + (16 + 4 * q) * 4), g2 = *(const f32x4*)(sb + O_GAM + (32 + 4 * q) * 4), g3 = *(const f32x4*)(sb + O_GAM + (48 + 4 * q) * 4);
                const uint2 vt = *(const uint2*)(sb + O_VT + ((cw * 4 + q) * 16 + i16) * 8);
                asm volatile("s_waitcnt lgkmcnt(0)" ::: "memory");
                __builtin_amdgcn_fence(__ATOMIC_RELEASE, "workgroup");
                if (lane == 0) __hip_atomic_store(done + cw, c + 1, __ATOMIC_RELAXED, __HIP_MEMORY_SCOPE_WORKGROUP);
                const bf16x8 sb0 = (bf16x8)(u32x4){cvt_pk_bf16(S0[0], S0[1]), cvt_pk_bf16(S0[2], S0[3]), cvt_pk_bf16(S1[0], S1[1]), cvt_pk_bf16(S1[2], S1[3])};
                const bf16x8 sb1 = (bf16x8)(u32x4){cvt_pk_bf16(S2[0], S2[1]), cvt_pk_bf16(S2[2], S2[3]), cvt_pk_bf16(S3[0], S3[1]), cvt_pk_bf16(S3[2], S3[3])};
                const bf16x8 uv0 = (bf16x8)(u32x4){0u, 0u, vt.x, vt.y};
                f32x4 U = __builtin_amdgcn_mfma_f32_16x16x32_bf16(w10, sb0, zero4, 0, 0, 0);
                U = __builtin_amdgcn_mfma_f32_16x16x32_bf16(w11, sb1, U, 0, 0, 0);
                U = __builtin_amdgcn_mfma_f32_16x16x32_bf16(mak, uv0, U, 0, 0, 0);
                { const bf16x8 xv = (bf16x8)(u32x4){cvt_pk_bf16(U[0], U[1]), cvt_pk_bf16(U[2], U[3]), 0u, 0u}; U = __builtin_amdgcn_mfma_f32_16x16x32_bf16(ti, xv, zero4, 0, 0, 0); }
                f32x4 Yv = __builtin_amdgcn_mfma_f32_16x16x32_bf16(rr0, sb0, zero4, 0, 0, 0);
                Yv = __builtin_amdgcn_mfma_f32_16x16x32_bf16(rr1, sb1, Yv, 0, 0, 0);
                const bf16x8 uv = (bf16x8)(u32x4){cvt_pk_bf16(U[0], U[1]), cvt_pk_bf16(U[2], U[3]), vt.x, vt.y};
                Yv = __builtin_amdgcn_mfma_f32_16x16x32_bf16(pp, uv, Yv, 0, 0, 0);
                S0 = __builtin_amdgcn_mfma_f32_16x16x32_bf16(bk0, uv, S0, 0, 0, 0);
                S1 = __builtin_amdgcn_mfma_f32_16x16x32_bf16(bk1, uv, S1, 0, 0, 0);
                S2 = __builtin_amdgcn_mfma_f32_16x16x32_bf16(bk2, uv, S2, 0, 0, 0);
                S3 = __builtin_amdgcn_mfma_f32_16x16x32_bf16(bk3, uv, S3, 0, 0, 0);
                S0 *= g0; S1 *= g1; S2 *= g2; S3 *= g3;
                if (c >= 16) { const int t0 = T0(c);
#pragma unroll
                    for (int e = 0; e < 4; ++e) { const int t = 4 * q + e, tp = t0 + (d ? 15 - t : t);
                        Y[(size_t)(b * T + tp - TCX) * 1024 + h * 64 + half * 32 + cw * 16 + i16] = f2bf(Yv[e]); } }
            }
        } else {
#define T0D(c) (DD == 0 ? 16 * (c) : ((c) < 16 ? 240 - 16 * (c) : 4592 - 16 * (c)))
            auto producer = [&](auto dc) {
                constexpr int DD = decltype(dc)::value;
            const int pw = wave - 2, k = lane, m4 = k >> 4, i16 = lane & 15, q = lane >> 4;
            const int arr_off = ((m4 >> 1) * 4 + ((k >> 2) & 3)) * BLK + ((m4 & 1) * 4 + (k & 3)) * 2;
            unsigned char* scr = lds + O_SCR + pw * SCRW;
            float* nabf = (float*)(scr + 4352); float* nakf = (float*)(scr + 5376);
            const float kac = P.in[15][h * 64 + k];
            const int vl = lane & 31, th = lane >> 5;
            float nl[16], kq[16], aa[16], kr[16], rr[16], vv[8];
#define PLOAD(cc) do { const size_t o_ = base + (size_t)T0D(cc) * 64 + k; const bf16_t* pN = NL + o_; const bf16_t* pQ = KKr + o_; const bf16_t* pA = AA + o_; const bf16_t* pK = Kr + o_; const bf16_t* pR = Rr + o_; \
                const bf16_t* pV = Vr + base + (size_t)T0D(cc) * 64 + half * 32 + vl + (DD ? (15 - th * 8) * 64 : th * 8 * 64); \
                _Pragma("unroll") for (int i = 0; i < 16; ++i) { constexpr int dummy_ = 0; const int ofs = (DD ? 15 - i : i) * 64 + dummy_; \
                    nl[i] = bf2f(pN[ofs]); kq[i] = bf2f(pQ[ofs]); aa[i] = bf2f(pA[ofs]); kr[i] = bf2f(pK[ofs]); rr[i] = bf2f(pR[ofs]); } \
                _Pragma("unroll") for (int u = 0; u < 8; ++u) vv[u] = bf2f(pV[(DD ? -u : u) * 64]); } while (0)
            PLOAD(pw);
            for (int c = pw; c < 272; c += 6) {
                const int slot = c % NSLOT; unsigned char* sb = lds + slot * SLOT;
                for (;;) { const int d0 = __hip_atomic_load(done, __ATOMIC_ACQUIRE, __HIP_MEMORY_SCOPE_WORKGROUP), d1 = __hip_atomic_load(done + 1, __ATOMIC_ACQUIRE, __HIP_MEMORY_SCOPE_WORKGROUP);
                    if (__builtin_amdgcn_readfirstlane(d0 < d1 ? d0 : d1) >= c - 6) break; __builtin_amdgcn_s_sleep(1); }
                float al[16], be4[4], ka4[4]; float cs = 0.f, gp = 1.f;
#pragma unroll
                for (int i = 0; i < 16; ++i) { cs += nl[i]; const float g = __expf(-cs), ig = __expf(cs);
                    al[i] = gp * kq[i]; const float be = kq[i] * aa[i] * ig, ka = kr[i] * (1.f + (aa[i] - 1.f) * kac) * ig, rh = g * rr[i]; gp = g;
                    *(bf16_t*)(sb + O_W1 + arr_off + i * 16) = f2bf(al[i]); *(bf16_t*)(sb + O_RR + arr_off + i * 16) = f2bf(rh);
                    *(bf16_t*)(scr + arr_off + i * 16) = f2bf(be); *(bf16_t*)(scr + 2176 + arr_off + i * 16) = f2bf(ka);
                    be4[i & 3] = -be; ka4[i & 3] = ka;
                    if ((i & 3) == 3) { uint4 u; u.x = cvt_pk_bf16(be4[0], be4[1]); u.y = cvt_pk_bf16(be4[2], be4[3]); u.z = cvt_pk_bf16(ka4[0], ka4[1]); u.w = cvt_pk_bf16(ka4[2], ka4[3]);
                        *(uint4*)(sb + O_BK + ((m4 * 4 + (i >> 2)) * 16 + (k & 15)) * 16) = u; } }
                *(float*)(sb + O_GAM + k * 4) = gp;
#pragma unroll
                for (int u = 0; u < 8; ++u) { const int i = th * 8 + u; *(bf16_t*)(sb + O_VT + (((vl >> 4) * 4 + (i >> 2)) * 16 + (vl & 15)) * 8 + (i & 3) * 2) = f2bf(vv[u]); }
                if (c + 6 < 272) PLOAD(c + 6);
                const int fo = (q * 16 + i16) * 16;
                const int fp = q * BLK + i16 * 16;
                const bf16x8 al0 = *(const bf16x8*)(sb + O_W1 + fp), al1 = *(const bf16x8*)(sb + O_W1 + 4 * BLK + fp), rh0 = *(const bf16x8*)(sb + O_RR + fp), rh1 = *(const bf16x8*)(sb + O_RR + 4 * BLK + fp);
                const bf16x8 be0 = *(const bf16x8*)(scr + fp), be1 = *(const bf16x8*)(scr + 4 * BLK + fp), ka0 = *(const bf16x8*)(scr + 2176 + fp), ka1 = *(const bf16x8*)(scr + 2176 + 4 * BLK + fp);
                const f32x4 z4 = {0.f, 0.f, 0.f, 0.f};
                f32x4 nab = __builtin_amdgcn_mfma_f32_16x16x32_bf16(al0, be0, z4, 0, 0, 0); nab = __builtin_amdgcn_mfma_f32_16x16x32_bf16(al1, be1, nab, 0, 0, 0);
                f32x4 nak = __builtin_amdgcn_mfma_f32_16x16x32_bf16(al0, ka0, z4, 0, 0, 0); nak = __builtin_amdgcn_mfma_f32_16x16x32_bf16(al1, ka1, nak, 0, 0, 0);
                f32x4 prb = __builtin_amdgcn_mfma_f32_16x16x32_bf16(rh0, be0, z4, 0, 0, 0); prb = __builtin_amdgcn_mfma_f32_16x16x32_bf16(rh1, be1, prb, 0, 0, 0);
                f32x4 prk = __builtin_amdgcn_mfma_f32_16x16x32_bf16(rh0, ka0, z4, 0, 0, 0); prk = __builtin_amdgcn_mfma_f32_16x16x32_bf16(rh1, ka1, prk, 0, 0, 0);
#pragma unroll
                for (int e = 0; e < 4; ++e) { const int t = 4 * q + e;
                    nabf[t * 16 + i16] = (i16 < t) ? nab[e] : 0.f;
                    unsigned char* ppp = sb + O_PP + (((i16 >> 2) * 16 + t) * 8 + (i16 & 3)) * 2;
                    *(bf16_t*)(ppp) = f2bf((i16 <= t) ? -prb[e] : 0.f); *(bf16_t*)(ppp + 8) = f2bf((i16 <= t) ? prk[e] : 0.f);
                    unsigned char* mkp = sb + O_MAK + (((i16 >> 2) * 16 + t) * 8 + (i16 & 3)) * 2;
                    *(bf16_t*)(mkp) = 0; *(bf16_t*)(mkp + 8) = f2bf((i16 < t) ? nak[e] : 0.f); }
                float xr[16]; xr[0] = (i16 == 0) ? 1.f : 0.f;
                unsigned char* tip = sb + O_TI + (((i16 >> 2) * 16) * 8 + (i16 & 3)) * 2;
                if (lane < 16) { *(bf16_t*)(tip) = f2bf(xr[0]); *(bf16_t*)(tip + 8) = 0; }
#pragma unroll
                for (int t = 1; t < 16; ++t) {
                    float nrow[16];
#pragma unroll
                    for (int g4 = 0; g4 < 4; ++g4) if (g4 * 4 < t) { const f32x4 v4 = *(const f32x4*)(nabf + t * 16 + g4 * 4); nrow[g4 * 4] = v4[0]; nrow[g4 * 4 + 1] = v4[1]; nrow[g4 * 4 + 2] = v4[2]; nrow[g4 * 4 + 3] = v4[3]; }
                    float ax = (i16 == t) ? 1.f : 0.f;
#pragma unroll
                    for (int i = 0; i < t; ++i) ax -= nrow[i] * xr[i];
                    xr[t] = ax;
                    if (lane < 16) { *(bf16_t*)(tip + t * 16) = f2bf(ax); *(bf16_t*)(tip + t * 16 + 8) = 0; }
                }
                asm volatile("s_waitcnt lgkmcnt(0)" ::: "memory");
                __builtin_amdgcn_fence(__ATOMIC_RELEASE, "workgroup");
                if (lane == 0) __hip_atomic_store(flag + slot, c, __ATOMIC_RELAXED, __HIP_MEMORY_SCOPE_WORKGROUP);
            }
                    };
            if (d) producer(std::integral_constant<int, 1>{}); else producer(std::integral_constant<int, 0>{});
#undef T0D
        }
#undef PLOAD
#undef T0
    }
    __syncthreads();
}

#define XB_TMO      128
#define XB_XCNT(j)  (256  + 64 * (j))
#define XB_XSUB(j)  (1280 + 64 * (j))
#define XB_XGEN(j)  (2304 + 64 * (j))
#define XB_TOP      3328
#define XB_TOPGEN   3392
#define XCD_BAR_WORDS 3456
#define XB_SPIN_CAP (1u << 18)
__device__ __forceinline__ unsigned xb_ld(unsigned* p)              { return __hip_atomic_load(p, __ATOMIC_RELAXED, __HIP_MEMORY_SCOPE_AGENT); }
__device__ __forceinline__ unsigned xb_add(unsigned* p, unsigned v) { return __hip_atomic_fetch_add(p, v, __ATOMIC_RELAXED, __HIP_MEMORY_SCOPE_AGENT); }
__device__ __forceinline__ unsigned xb_xcc_id() { return (unsigned)__builtin_amdgcn_s_getreg((3 << 11) | 20) & 0xFu; }
#define XB_SPIN(cond, bar) do { unsigned _sp = 0; while (cond) { __builtin_amdgcn_s_sleep(1); \
    if ((++_sp & 255u) == 0u) { if (xb_ld(&(bar)[XB_TMO])) break; if (_sp > XB_SPIN_CAP) { atomicAdd(&(bar)[XB_TMO], 1u); break; } } } } while (0)
struct XcdBarrier { unsigned* bar; unsigned x; volatile LAS unsigned* st; };
__device__ __forceinline__ void xcd_barrier_complete(unsigned* bar, unsigned x, unsigned& nloc, unsigned& nx) {
    const unsigned G = gridDim.x;
    unsigned sum, cnt, mine, sp = 0u;
    for (;;) {
        sum = 0u; cnt = 0u; mine = 0u;
#pragma unroll
        for (unsigned j = 0; j < 16; ++j) { const unsigned c = xb_ld(&bar[XB_XCNT(j)]); sum += c; cnt += (c > 0u) ? 1u : 0u; mine = (j == x) ? c : mine; }
        if (sum == G) break;
        __builtin_amdgcn_s_sleep(1);
        if ((++sp & 255u) == 0u) { if (xb_ld(&bar[XB_TMO])) break; if (sp > XB_SPIN_CAP) { atomicAdd(&bar[XB_TMO], 1u); break; } }
    }
    nloc = mine > 0u ? mine : 1u; nx = cnt > 0u ? cnt : 1u;
}
__device__ __forceinline__ void xcd_barrier(const XcdBarrier& b, const int tid) {
    asm volatile("s_waitcnt vmcnt(0)" ::: "memory");
    __syncthreads();
    if (tid == 0) {
        unsigned* bar = b.bar;
        __builtin_amdgcn_s_waitcnt(0);
        unsigned nloc = b.st[0], nx = b.st[1];
        if (nloc == 0u) { xcd_barrier_complete(bar, b.x, nloc, nx); b.st[0] = nloc; b.st[1] = nx; }
        const unsigned old = xb_add(&bar[XB_XSUB(b.x)], 1u);
        const unsigned gen = old / nloc;
        if (old + 1u == (gen + 1u) * nloc) {
            __builtin_amdgcn_fence(__ATOMIC_RELEASE, "agent");
            asm volatile("s_waitcnt vmcnt(0)" ::: "memory");
            const unsigned og = xb_add(&bar[XB_TOP], 1u);
            const unsigned tg = og / nx;
            if (og + 1u == (tg + 1u) * nx) xb_add(&bar[XB_TOPGEN], 1u);
            else XB_SPIN(xb_ld(&bar[XB_TOPGEN]) == tg, bar);
            __builtin_amdgcn_fence(__ATOMIC_ACQUIRE, "agent");
            xb_add(&bar[XB_XGEN(b.x)], 1u);
            asm volatile("s_waitcnt vmcnt(0)" ::: "memory");
        } else {
            XB_SPIN(xb_ld(&bar[XB_XGEN(b.x)]) == gen, bar);
            __builtin_amdgcn_fence(__ATOMIC_ACQUIRE, "agent");
            asm volatile("s_waitcnt vmcnt(0)" ::: "memory");
        }
    }
    __syncthreads();
}

#ifndef MK_ONLY
#define MK_ONLY -1
#endif
#ifndef MK_REPMASK
#define MK_REPMASK 0x0
#endif
__global__ void __launch_bounds__(512) mk_fwd(Params P) {
    __builtin_assume(__builtin_amdgcn_workitem_id_y() == 0); __builtin_assume(__builtin_amdgcn_workitem_id_z() == 0);
    extern __shared__ __attribute__((aligned(16))) unsigned char shm[];
    cg::grid_group grid = cg::this_grid();
    LAS unsigned char* lds = (LAS unsigned char*)shm; float* ldsf = (float*)shm;
    unsigned char* ws = P.ws; unsigned char* dob = (unsigned char*)P.out;
    const int G = gridDim.x, c = blockIdx.x;
    const int wid_s = __builtin_amdgcn_readfirstlane((int)threadIdx.x >> 6);
#define PH_TID() ({ int l_; asm volatile("v_mbcnt_lo_u32_b32 %0, -1, 0\n\tv_mbcnt_hi_u32_b32 %0, -1, %0" : "=v"(l_)); wid_s * 64 + l_; })
    const float* mv = (const float*)(ws + WS_MODV);
#define EN(k) ((MK_ONLY < 0 || MK_ONLY == (k)) && P.ph_lo <= (k) && (k) < P.ph_hi)
    XcdBarrier xb; xb.bar = (unsigned*)(ws + WS_BAR); xb.x = xb_xcc_id(); xb.st = (volatile LAS unsigned*)(lds + 131072);
    if (P.ph_hi < 0) grid.sync();
    { const int t_ = PH_TID(); if (t_ < 2) xb.st[t_] = 0u; __syncthreads(); if (t_ == 0 && P.ph_hi - P.ph_lo > 1) (void)xb_add(&xb.bar[XB_XCNT(xb.x)], 1u); }
#define SYNC(k) do { if (P.ph_lo <= (k) && (k) + 1 < P.ph_hi) xcd_barrier(xb, PH_TID()); } while (0)
    if (EN(0)) for (int r_ = 0; r_ < ((MK_REPMASK >> 0) & 1) + 1; ++r_) { phase0(P, ldsf, PH_TID()); }
    SYNC(0);
    if (EN(1)) for (int r_ = 0; r_ < ((MK_REPMASK >> 1) & 1) + 1; ++r_) { phase0b(P, PH_TID()); }
    SYNC(1);
    if (EN(2)) for (int r_ = 0; r_ < ((MK_REPMASK >> 2) & 1) + 1; ++r_) { phase_norm_mod(P, 0, PH_TID()); }
    SYNC(2);
    if (EN(3)) for (int r_ = 0; r_ < ((MK_REPMASK >> 3) & 1) + 1; ++r_) { { pg8::StaticOrder S; S.init(MT, NINP, G, c); pg8::Gemm g{(const bf16_t*)(ws + WS_HX), (const bf16_t*)(ws + WS_WT_IN), 2048, 2048, 2048};
                  EpiStoreBf16 E{(bf16_t*)(ws + WS_P), NINP}; pg8::gemm_phase(lds, g, S, E, PH_TID()); } }
    SYNC(3);
    if (EN(4)) for (int r_ = 0; r_ < ((MK_REPMASK >> 4) & 1) + 1; ++r_) { phase_prep(P, PH_TID()); }
    SYNC(4);
    if (EN(5)) for (int r_ = 0; r_ < ((MK_REPMASK >> 5) & 1) + 1; ++r_) { {
            { pg8::GroupOrder S{G, c}; pg8::Gemm g{(const bf16_t*)(ws + WS_A2), (const bf16_t*)(ws + WS_BT_S5), 256, 512, 256}; EpiStoreF32 E{(float*)(ws + WS_W), 256}; pg8::gemm_phase(lds, g, S, E, PH_TID()); }
            { pg8::StaticOrder S; S.init(MT, 4096, G, (c + 128) % G);
              pg8::Gemm g{(const bf16_t*)(dob + DO_ASMALL), (const bf16_t*)(ws + WS_WT_WA), 256, 512, 256};
              EpiLoraWA E{(bf16_t*)(ws + WS_NLDF), (bf16_t*)(ws + WS_NLDB), (bf16_t*)(ws + WS_AF), (bf16_t*)(ws + WS_AB), P.in[9], P.in[11]}; pg8::gemm_phase(lds, g, S, E, PH_TID()); }
            { pg8::LatentOrder S{G, c}; pg8::Gemm g{(const bf16_t*)(dob + DO_ASMALL) + 256, (const bf16_t*)(ws + WS_WT_G), 256, 512, 256};
              EpiStoreBf16 E{(bf16_t*)(ws + WS_G), 1024}; pg8::gemm_phase(lds, g, S, E, PH_TID()); }
        } }
    SYNC(5);
    if (EN(6)) for (int r_ = 0; r_ < ((MK_REPMASK >> 6) & 1) + 1; ++r_) { { const int tid6 = PH_TID(); phase_s5_scan(P, tid6); phase_rwkv_scan(P, shm, tid6); } }
    SYNC(6);
    if (EN(7)) for (int r_ = 0; r_ < ((MK_REPMASK >> 7) & 1) + 1; ++r_) { {
            phase_post(P, PH_TID());
            { pg8::GroupOrder4 S{G, c}; pg8::Gemm g{(const bf16_t*)(ws + WS_A2), (const bf16_t*)(ws + WS_TC_S5), 512, 512, 512}; EpiS5Y E{(bf16_t*)(dob + DO_Z)}; pg8::gemm_phase(lds, g, S, E, PH_TID()); }
        } }
    SYNC(7);
    if (EN(8)) for (int r_ = 0; r_ < ((MK_REPMASK >> 8) & 1) + 1; ++r_) { { pg8::StaticOrder S; S.init(ML, 1024, G, c); pg8::Gemm g{(const bf16_t*)(dob + DO_Z), (const bf16_t*)(ws + WS_WT_GLU), 1024, 1024, 1024};
                  EpiGLU E{(const bf16_t*)(dob + DO_Z), (bf16_t*)(ws + WS_O), P.in[28]}; pg8::gemm_phase(lds, g, S, E, PH_TID()); } }
    SYNC(8);
    if (EN(9)) for (int r_ = 0; r_ < ((MK_REPMASK >> 9) & 1) + 1; ++r_) { { pg8::StaticOrder S; S.init(ML, 2048, G, c); pg8::Gemm g{(const bf16_t*)(ws + WS_O), (const bf16_t*)(ws + WS_WT_OUT), 2048, 2048, 2048};
                  EpiResid E{P.in[0], P.out, mv + 2 * 2048}; pg8::gemm_phase(lds, g, S, E, PH_TID()); } }
    SYNC(9);
    if (EN(10)) for (int r_ = 0; r_ < ((MK_REPMASK >> 10) & 1) + 1; ++r_) { { const int tid10 = PH_TID();
                 transpose_weight(P.in[31], 2 * DFF, 2 * DFF, 2048, 2 * DFF, 3, (bf16_t*)(ws + WS_WT_UP), tid10);
                 transpose_weight(P.in[34], 2048, 2048, DFF, 2048, 4, (bf16_t*)(ws + WS_WT_DOWN), tid10, 5632);
                 phase_norm_mod(P, 1, tid10); } }
    SYNC(10);
    if (EN(11)) for (int r_ = 0; r_ < ((MK_REPMASK >> 11) & 1) + 1; ++r_) { { pg8::StaticOrder S; S.init(ML, 2 * DFF, G, c); pg8::Gemm g{(const bf16_t*)(ws + WS_HX2), (const bf16_t*)(ws + WS_WT_UP), 2048, 2048, 2048};
                   EpiFFNUp E{(bf16_t*)(ws + WS_H), P.in[32], P.in[33]}; pg8::gemm_phase(lds, g, S, E, PH_TID()); } }
    SYNC(11);
    if (EN(12)) for (int r_ = 0; r_ < ((MK_REPMASK >> 12) & 1) + 1; ++r_) { { pg8::StaticOrder S; S.init(ML, 2048, G, c); pg8::Gemm g{(const bf16_t*)(ws + WS_H), (const bf16_t*)(ws + WS_WT_DOWN), DFF, DFF, DFF};
                   EpiResid E{P.out, P.out, mv + 5 * 2048}; pg8::gemm_phase(lds, g, S, E, PH_TID()); } }
    SYNC(12);
    if (EN(13)) for (int r_ = 0; r_ < ((MK_REPMASK >> 13) & 1) + 1; ++r_) { phase_final_norm(P, PH_TID()); }
    SYNC(13);
}

#ifndef MK_PER_PHASE
#define MK_PER_PHASE 0
#endif
extern "C" void kernel_launch(void* const* d_in, const int* in_sizes, int n_in, void* d_out, int out_size, void* d_ws, size_t ws_size, hipStream_t stream) {
    static int grid = 0;
    if (grid == 0) {
        if (n_in != 36 || out_size != ML * D || ws_size < WS_NEED) { fprintf(stderr, "kernel_launch: unexpected shapes (n_in %d out %d ws %zu)\n", n_in, out_size, ws_size); grid = -1; return; }
        int dev = 0, cus = 0, per_cu = 0;
        hipGetDevice(&dev); hipDeviceGetAttribute(&cus, hipDeviceAttributeMultiprocessorCount, dev);
        hipFuncSetAttribute((const void*)mk_fwd, hipFuncAttributeMaxDynamicSharedMemorySize, LDS_BYTES);
        hipOccupancyMaxActiveBlocksPerMultiprocessor(&per_cu, (const void*)mk_fwd, 512, LDS_BYTES);
        if (per_cu < 1) { fprintf(stderr, "kernel_launch: occupancy query says %d blocks per CU\n", per_cu); per_cu = 1; }
        grid = cus;
        (void)hipGetLastError();
    }
    if (grid < 0) return;
    Params p{};
    for (int i = 0; i < 36; ++i) p.in[i] = (const float*)d_in[i];
    p.out = (float*)d_out; p.ws = (unsigned char*)d_ws;
#if MK_PER_PHASE
    for (int ph = 0; ph < 14; ++ph) { p.ph_lo = ph; p.ph_hi = ph + 1; hipLaunchKernelGGL(mk_fwd, dim3(grid), dim3(512), LDS_BYTES, stream, p); }
#else
    p.ph_lo = 0; p.ph_hi = 14;
    if (hipMemsetAsync((char*)d_ws + WS_BAR, 0, 3456 * sizeof(unsigned), stream) != hipSuccess) { fprintf(stderr, "kernel_launch: memset of the barrier words failed\n"); return; }
    void* args[] = {&p};
    hipError_t e = hipLaunchCooperativeKernel((const void*)mk_fwd, dim3(grid), dim3(512), args, LDS_BYTES, stream);
    if (e != hipSuccess) fprintf(stderr, "cooperative launch failed: %s (grid %d)\n", hipGetErrorString(e), grid);
#endif
}
```
